# Optimizing an MI355X kernel written in HIP

```python
import math
import jax, jax.numpy as jnp
from jax import lax
import numpy as np

D_MODEL = 1024
BATCH = 2
SEQ = 8192
DEPTH = 1
DEC_BATCH = 128
DEC_SEQ = 4
PAST_LEN = 2048
PAGE_SIZE = 128

SB_HEADS = 8
SB_HEAD_DIM = D_MODEL // 16
SB_DIM = SB_HEADS * SB_HEAD_DIM
SB_Q_BLOCK = 128
SB_BIAS_LO = -7.0
SB_BIAS_HI = -5.0
GDN_HEADS = 4
GDN_HEAD_DIM = D_MODEL // 8
GDN_DIM = GDN_HEADS * GDN_HEAD_DIM
CONV_WIDTH = 4
CONV_DIM = 3 * GDN_DIM
GDN_CHUNK = 64
D_FF = 4 * D_MODEL
NORM_EPS = 1e-6
L2_EPS = 1e-6
IN_SPLITS = (SB_DIM, SB_DIM, SB_DIM, CONV_DIM, GDN_DIM, GDN_HEADS, GDN_HEADS, D_MODEL, D_MODEL)
IN_DIM = sum(IN_SPLITS)

kernel_name = "stickbreak_gdn_parallel_hybrid_step"

F32 = jnp.float32


def rmsnorm(x, w):
    xf = x.astype(F32)
    return xf * lax.rsqrt(jnp.mean(xf * xf, axis=-1, keepdims=True) + NORM_EPS) * w.astype(F32)


def l2norm(x):
    return x * lax.rsqrt(jnp.sum(x * x, axis=-1, keepdims=True) + L2_EPS)


def stick_breaking(q, k, v, q_pos, k_pos, sb_bias):
    z = (jnp.einsum('bqhd,bkhd->bhqk', q, k) * (q.shape[-1] ** -0.5)
         + sb_bias.astype(F32)[None, :, None, None])
    mask = k_pos[None, :] < q_pos[:, None]
    log_1m = jnp.where(mask, jax.nn.log_sigmoid(-z), 0.0)
    suffix = lax.cumsum(log_1m, axis=3, reverse=True) - log_1m
    w = jnp.where(mask, jnp.exp(jax.nn.log_sigmoid(z) + suffix), 0.0)
    return jnp.einsum('bhqk,bkhd->bqhd', w, v)


def sb_prompt(q, k, v, sb_bias):
    bsz, t_len, n_h, d = q.shape
    n_blk = t_len // SB_Q_BLOCK
    qb = jnp.moveaxis(q.reshape(bsz, n_blk, SB_Q_BLOCK, n_h, d), 1, 0)
    pb = jnp.arange(t_len).reshape(n_blk, SB_Q_BLOCK)
    k_pos = jnp.arange(t_len)
    out = lax.map(lambda a: stick_breaking(a[0], k, v, a[1], k_pos, sb_bias), (qb, pb))
    return jnp.moveaxis(out, 0, 1).reshape(bsz, t_len, n_h, d)


def sb_extend(q, k, v, k_past, v_past, sb_bias):
    past = k_past.shape[1]
    t_len = q.shape[1]
    k_all = jnp.concatenate([k_past, k], axis=1)
    v_all = jnp.concatenate([v_past, v], axis=1)
    q_pos = past + jnp.arange(t_len)
    k_pos = jnp.arange(past + t_len)
    return stick_breaking(q, k_all, v_all, q_pos, k_pos, sb_bias)


def short_conv(u_ext, w_conv):
    out = lax.conv_general_dilated(u_ext, w_conv[:, None, :], window_strides=(1,), padding='VALID',
                                   dimension_numbers=('NWC', 'WIO', 'NWC'),
                                   feature_group_count=u_ext.shape[-1])
    return jax.nn.silu(out)


def gated_delta_chunked(q, k, v, g, beta, s0, chunk):
    bsz, t_len, n_h, _ = q.shape
    d_v = v.shape[-1]
    n_chunks = t_len // chunk

    def to_chunks(a):
        a = a.reshape((bsz, n_chunks, chunk) + a.shape[2:])
        return jnp.moveaxis(jnp.swapaxes(a, 2, 3), 1, 0)

    incl = jnp.tril(jnp.ones((chunk, chunk), dtype=bool))
    strict = jnp.tril(jnp.ones((chunk, chunk), dtype=bool), -1)
    eye = jnp.eye(chunk, dtype=F32)

    def step(s, inp):
        qc, kc, vc, gc, bc = inp
        cg = jnp.cumsum(gc, axis=-1)
        decay = jnp.exp(jnp.where(incl, cg[..., :, None] - cg[..., None, :], -jnp.inf))
        m = jnp.where(strict, bc[..., :, None] * jnp.einsum('bhik,bhjk->bhij', kc, kc) * decay, 0.0)
        rhs = jnp.concatenate([vc * bc[..., None], kc * (bc * jnp.exp(cg))[..., None]], axis=-1)
        sol = lax.linalg.triangular_solve(eye + m, rhs, left_side=True, lower=True, unit_diagonal=True)
        u, w = sol[..., :d_v], sol[..., d_v:]
        v_new = u - jnp.einsum('bhck,bhkv->bhcv', w, s)
        o = (jnp.einsum('bhck,bhkv->bhcv', qc * jnp.exp(cg)[..., None], s)
             + jnp.einsum('bhij,bhjv->bhiv', jnp.einsum('bhik,bhjk->bhij', qc, kc) * decay, v_new))
        g_last = cg[..., -1:]
        s = s * jnp.exp(g_last)[..., None] + jnp.einsum('bhck,bhcv->bhkv', kc * jnp.exp(g_last - cg)[..., None], v_new)
        return s, o

    s_fin, o = lax.scan(step, s0, (to_chunks(q), to_chunks(k), to_chunks(v), to_chunks(g), to_chunks(beta)))
    o = jnp.swapaxes(jnp.moveaxis(o, 0, 1), 2, 3).reshape(bsz, t_len, n_h, d_v)
    return o, s_fin


def gdn_branch(conv_out, z, a, b, s0, a_log, dt_bias, gdn_norm_w):
    bsz, t_len, _ = conv_out.shape
    q, k, v = jnp.split(conv_out, 3, axis=-1)
    shp = (bsz, t_len, GDN_HEADS, GDN_HEAD_DIM)
    q = l2norm(q.reshape(shp)) * (GDN_HEAD_DIM ** -0.5)
    k = l2norm(k.reshape(shp))
    v = v.reshape(shp)
    beta = jax.nn.sigmoid(b)
    g = -jnp.exp(a_log.astype(F32)) * jax.nn.softplus(a + dt_bias.astype(F32))
    chunk = math.gcd(GDN_CHUNK, t_len)
    o, s_new = gated_delta_chunked(q, k, v, g, beta, s0.astype(F32), chunk)
    o = o * lax.rsqrt(jnp.mean(o * o, axis=-1, keepdims=True) + NORM_EPS) * gdn_norm_w.astype(F32)
    o = o * jax.nn.silu(z.reshape(shp))
    return o.reshape(bsz, t_len, GDN_DIM), s_new


def decoder_layer(x, k_past, v_past, conv_prev, ssm_prev, norm_mix_w, w_in, sb_bias, conv_w, a_log, dt_bias,
                  gdn_norm_w, w_pa, w_pb, w_o, norm_mlp_w, w_up, w_down):
    bsz, t_len, _ = x.shape
    h = rmsnorm(x, norm_mix_w)
    p = h @ w_in.astype(F32)
    q_a, k_a, v_a, u, z, a, b, g_a, g_b = jnp.split(p, [int(i) for i in np.cumsum(IN_SPLITS)[:-1]], axis=-1)
    hs = (bsz, t_len, SB_HEADS, SB_HEAD_DIM)
    q_a, k_a, v_a = q_a.reshape(hs), k_a.reshape(hs), v_a.reshape(hs)
    if k_past is None:
        o_a = sb_prompt(q_a, k_a, v_a, sb_bias)
    else:
        o_a = sb_extend(q_a, k_a, v_a, k_past.astype(F32), v_past.astype(F32), sb_bias)
    u_ext = jnp.concatenate([conv_prev.astype(F32), u], axis=1)
    conv_new = u_ext[:, -(CONV_WIDTH - 1):]
    o_b, ssm_new = gdn_branch(short_conv(u_ext, conv_w.astype(F32)), z, a, b, ssm_prev, a_log, dt_bias, gdn_norm_w)
    y_a = o_a.reshape(bsz, t_len, SB_DIM) @ w_pa.astype(F32)
    y_b = o_b @ w_pb.astype(F32)
    mix = (jax.nn.sigmoid(g_a) * y_a + jax.nn.sigmoid(g_b) * y_b) @ w_o.astype(F32)
    x = x + mix
    hm = rmsnorm(x, norm_mlp_w)
    x = x + jnp.square(jax.nn.relu(hm @ w_up.astype(F32))) @ w_down.astype(F32)
    return x, k_a, v_a, conv_new, ssm_new


def setup_inputs(seed: int = 0) -> dict:
    key = jax.random.key(seed)
    ks = jax.random.split(key, 24)
    n_pages = PAST_LEN // PAGE_SIZE
    n_used = DEC_BATCH * n_pages
    n_pool = n_used + n_used // 4
    nrm = jax.random.normal
    x_prompt = nrm(ks[0], (BATCH, SEQ, D_MODEL), F32)
    x_sample = nrm(ks[1], (DEC_BATCH, DEC_SEQ, D_MODEL), F32)
    cache_k = nrm(ks[2], (DEPTH, n_pool, PAGE_SIZE, SB_HEADS, SB_HEAD_DIM), F32)
    cache_v = nrm(ks[3], (DEPTH, n_pool, PAGE_SIZE, SB_HEADS, SB_HEAD_DIM), F32)
    page_table = jax.random.permutation(ks[4], n_pool)[:n_used].reshape(DEC_BATCH, n_pages).astype(jnp.int32)
    state_conv = nrm(ks[5], (DEPTH, DEC_BATCH, CONV_WIDTH - 1, CONV_DIM), F32)
    state_ssm = 0.1 * nrm(ks[6], (DEPTH, DEC_BATCH, GDN_HEADS, GDN_HEAD_DIM, GDN_HEAD_DIM), F32)
    norm_mix_w = 1.0 + 0.02 * nrm(ks[7], (DEPTH, D_MODEL), F32)
    w_in = nrm(ks[8], (DEPTH, D_MODEL, IN_DIM), F32) * D_MODEL ** -0.5
    sb_bias = jax.random.uniform(ks[20], (DEPTH, SB_HEADS), F32, SB_BIAS_LO, SB_BIAS_HI)
    conv_w = nrm(ks[9], (DEPTH, CONV_WIDTH, CONV_DIM), F32) * CONV_WIDTH ** -0.5
    a_log = jnp.log(jax.random.uniform(ks[10], (DEPTH, GDN_HEADS), F32, 1.0, 16.0))
    dt = jnp.exp(jax.random.uniform(ks[11], (DEPTH, GDN_HEADS), F32, math.log(1e-3), math.log(1e-1)))
    dt_bias = dt + jnp.log(-jnp.expm1(-dt))
    gdn_norm_w = 1.0 + 0.02 * nrm(ks[12], (DEPTH, GDN_HEAD_DIM), F32)
    w_pa = nrm(ks[13], (DEPTH, SB_DIM, D_MODEL), F32) * SB_DIM ** -0.5
    w_pb = nrm(ks[14], (DEPTH, GDN_DIM, D_MODEL), F32) * GDN_DIM ** -0.5
    w_o = nrm(ks[15], (DEPTH, D_MODEL, D_MODEL), F32) * D_MODEL ** -0.5
    norm_mlp_w = 1.0 + 0.02 * nrm(ks[16], (DEPTH, D_MODEL), F32)
    w_up = nrm(ks[17], (DEPTH, D_MODEL, D_FF), F32) * D_MODEL ** -0.5
    w_down = nrm(ks[18], (DEPTH, D_FF, D_MODEL), F32) * D_FF ** -0.5
    norm_final_w = 1.0 + 0.02 * nrm(ks[19], (D_MODEL,), F32)
    return {"x_prompt": x_prompt, "x_sample": x_sample, "cache_k": cache_k, "cache_v": cache_v,
            "page_table": page_table, "state_conv": state_conv, "state_ssm": state_ssm,
            "norm_mix_w": norm_mix_w, "w_in": w_in, "sb_bias": sb_bias, "conv_w": conv_w, "a_log": a_log,
            "dt_bias": dt_bias, "gdn_norm_w": gdn_norm_w, "w_pa": w_pa, "w_pb": w_pb, "w_o": w_o,
            "norm_mlp_w": norm_mlp_w, "w_up": w_up, "w_down": w_down, "norm_final_w": norm_final_w}


def reference(x_prompt, x_sample, cache_k, cache_v, page_table, state_conv, state_ssm,
              norm_mix_w, w_in, sb_bias, conv_w, a_log, dt_bias, gdn_norm_w, w_pa, w_pb, w_o,
              norm_mlp_w, w_up, w_down, norm_final_w):
    b_p = x_prompt.shape[0]
    b_s = x_sample.shape[0]
    h_p = x_prompt.astype(F32)
    h_s = x_sample.astype(F32)
    conv0 = jnp.zeros((b_p, CONV_WIDTH - 1, CONV_DIM), F32)
    ssm0 = jnp.zeros((b_p, GDN_HEADS, GDN_HEAD_DIM, GDN_HEAD_DIM), F32)
    kp_l, vp_l, ks_l, vs_l, cp_l, cs_l, sp_l, ss_l = [], [], [], [], [], [], [], []
    for l in range(DEPTH):
        lw = (norm_mix_w[l], w_in[l], sb_bias[l], conv_w[l], a_log[l], dt_bias[l], gdn_norm_w[l], w_pa[l],
              w_pb[l], w_o[l], norm_mlp_w[l], w_up[l], w_down[l])
        h_p, k_p, v_p, c_p, s_p = decoder_layer(h_p, None, None, conv0, ssm0, *lw)
        k_past = cache_k[l][page_table].reshape(b_s, -1, SB_HEADS, SB_HEAD_DIM)
        v_past = cache_v[l][page_table].reshape(b_s, -1, SB_HEADS, SB_HEAD_DIM)
        h_s, k_s, v_s, c_s, s_s = decoder_layer(h_s, k_past, v_past, state_conv[l], state_ssm[l], *lw)
        kp_l.append(k_p); vp_l.append(v_p); ks_l.append(k_s); vs_l.append(v_s)
        cp_l.append(c_p); cs_l.append(c_s); sp_l.append(s_p); ss_l.append(s_s)
    y_prompt = rmsnorm(h_p, norm_final_w).astype(x_prompt.dtype)
    y_sample = rmsnorm(h_s, norm_final_w).astype(x_sample.dtype)
    page_shape = (DEPTH, b_p, -1, PAGE_SIZE, SB_HEADS, SB_HEAD_DIM)
    new_k_prompt = jnp.stack(kp_l).reshape(page_shape).astype(cache_k.dtype)
    new_v_prompt = jnp.stack(vp_l).reshape(page_shape).astype(cache_v.dtype)
    new_k_sample = jnp.stack(ks_l).astype(cache_k.dtype)
    new_v_sample = jnp.stack(vs_l).astype(cache_v.dtype)
    new_conv_prompt = jnp.stack(cp_l).astype(state_conv.dtype)
    new_conv_sample = jnp.stack(cs_l).astype(state_conv.dtype)
    new_ssm_prompt = jnp.stack(sp_l).astype(state_ssm.dtype)
    new_ssm_sample = jnp.stack(ss_l).astype(state_ssm.dtype)
    return (y_prompt, y_sample, new_k_prompt, new_v_prompt, new_k_sample, new_v_sample,
            new_conv_prompt, new_conv_sample, new_ssm_prompt, new_ssm_sample)
```

```cpp
#include <hip/hip_runtime.h>
#include <cstdio>
#include <cstdint>

#ifndef MK_N_LAUNCHES
#define MK_N_LAUNCHES 1
#endif

namespace pg8 {
#define PG8_LAS __attribute__((address_space(3)))
typedef unsigned short bf16_t;
typedef short bf16x8 __attribute__((ext_vector_type(8)));
typedef float f32x4 __attribute__((ext_vector_type(4)));
typedef unsigned u32x4 __attribute__((ext_vector_type(4)));
constexpr int BM = 256, BK = 64, HALF = 128, HTB = HALF * BK * 2  , STAGE_BYTES = 8 * HTB, NXCD = 8, WGM = 8;

__host__ __device__ __forceinline__ int lds_byte(int r, int c) { const int st = (r >> 4) * 2 + (c >> 5), rr = r & 15, cc = c & 31, ob = rr * 64 + cc * 2; return st * 1024 + (ob ^ (((ob >> 9) & 1) << 5)); }
__host__ __device__ __forceinline__ void stage_rc(int b, int& R, int& C) { const int st = b / 1024, sb = b % 1024, swz = sb ^ (((sb >> 9) & 1) << 5); R = (st >> 1) * 16 + swz / 64; C = (st & 1) * 32 + (swz % 64) / 2; }
__host__ __device__ __forceinline__ int perm32(int rho) { const int n = rho >> 4, i = rho & 15; return 8 * (i >> 2) + 4 * n + (i & 3); }

struct Unit { int pm, pn, ko; };
struct Gemm { const bf16_t* A; const bf16_t* Bt; int M, N, K, ld; };
typedef float f32x2_t __attribute__((ext_vector_type(2))); typedef __bf16 bf16x2_t __attribute__((ext_vector_type(2)));
__device__ __forceinline__ unsigned cvt_pk_bf16(float lo, float hi) { f32x2_t v = {lo, hi}; bf16x2_t b = __builtin_convertvector(v, bf16x2_t); return __builtin_bit_cast(unsigned, b); }


template <class Epi, class Sched, bool ALIGN_EPI = false, bool SP2 = false>
__device__ __forceinline__ void gemm_phase(PG8_LAS unsigned char* lds, const Gemm g, const Sched& S, const Epi& E) {
    const int tid = threadIdx.x, wid = __builtin_amdgcn_readfirstlane(tid >> 6), lane = tid & 63, wr = wid >> 2, wc = wid & 3, fr = lane & 15, fq = lane >> 4;
    const int K = g.ld, nt = g.K / BK;
    unsigned voffA[2], voffB[2];
#pragma unroll
    for (int i = 0; i < 2; ++i) { int R, C; stage_rc(tid * 16 + i * 8192, R, C); const int Rb = Epi::PERM ? ((R & ~31) + perm32(R & 31)) : R;
        voffA[i] = (unsigned)(R * K + C) * 2u; voffB[i] = (unsigned)(Rb * K + C) * 2u; }
    const size_t kstep = (size_t)(BK * 2);
    const size_t hstep = (size_t)HALF * K * 2;
    const size_t tstep = 2 * hstep;
    const unsigned ldsw = (unsigned)wid * 1024u;
    const int aoff = lds_byte(wr * 64 + fr, fq * 8), boff = lds_byte(wc * 32 + fr, fq * 8);
#define PG8_SA(b, h) (((b) * 2 + (h)) * HTB)
#define PG8_SB(b, h) ((4 + (b) * 2 + (h)) * HTB)
#define PG8_STAGE(bufoff, gbase, voff) do { _Pragma("unroll") for (int _i = 0; _i < 2; ++_i) \
        __builtin_amdgcn_global_load_lds((const unsigned*)((const char*)(gbase) + (voff)[_i]), (PG8_LAS unsigned*)(lds + (bufoff) + ldsw + _i * 8192), 16, 0, 0); } while (0)
#define PG8_LDA(dst, b, h) do { _Pragma("unroll") for (int m = 0; m < 4; ++m) _Pragma("unroll") for (int k = 0; k < 2; ++k) dst[m][k] = *(const PG8_LAS bf16x8*)(lds + PG8_SA(b, h) + aoff + m * 2048 + k * 1024); } while (0)
#define PG8_LDB(dst, b, h) do { _Pragma("unroll") for (int n = 0; n < 2; ++n) _Pragma("unroll") for (int k = 0; k < 2; ++k) dst[n][k] = *(const PG8_LAS bf16x8*)(lds + PG8_SB(b, h) + boff + n * 2048 + k * 1024); } while (0)
#define PG8_MMA(ai, bj, At, Bt) do { __builtin_amdgcn_s_setprio(1); _Pragma("unroll") for (int m = 0; m < 4; ++m) _Pragma("unroll") for (int n = 0; n < 2; ++n) _Pragma("unroll") for (int k = 0; k < 2; ++k) \
        acc[ai][bj][m][n] = __builtin_amdgcn_mfma_f32_16x16x32_bf16(Bt[n][k], At[m][k], acc[ai][bj][m][n], 0, 0, 0); __builtin_amdgcn_s_setprio(0); } while (0)
#define PG8_WAIT_V(n) asm volatile("s_waitcnt vmcnt(" #n ")" ::: "memory")
#define PG8_WAIT_L(n) asm volatile("s_waitcnt lgkmcnt(" #n ")" ::: "memory")
#define PG8_BAR __builtin_amdgcn_s_barrier()
#define PG8_SCHED __builtin_amdgcn_sched_barrier(0)
    Unit cur, nxt; int ui = 0;
    if (!S.next(0, cur)) return;
    f32x4 acc[2][2][4][2];
#pragma unroll
    for (int a = 0; a < 2; ++a)
#pragma unroll
        for (int b = 0; b < 2; ++b)
#pragma unroll
            for (int m = 0; m < 4; ++m)
#pragma unroll
                for (int n = 0; n < 2; ++n) acc[a][b][m][n] = (f32x4){0.f, 0.f, 0.f, 0.f};
    bf16x8 At[4][2], B0[2][2], B1[2][2];
    const char* cA = (const char*)g.A + (size_t)cur.pm * tstep + (size_t)cur.ko * 2; const char* cB = (const char*)g.Bt + (size_t)cur.pn * tstep + (size_t)cur.ko * 2;
    S.a_ready(cur);
    if constexpr (SP2) {
        PG8_STAGE(PG8_SB(0, 0), cB, voffB); PG8_STAGE(PG8_SB(0, 1), cB + hstep, voffB); PG8_STAGE(PG8_SA(0, 0), cA, voffA); PG8_STAGE(PG8_SA(0, 1), cA + hstep, voffA);
        if (wr == 1) PG8_BAR;
        PG8_WAIT_V(2); PG8_BAR;
        PG8_STAGE(PG8_SB(1, 0), cB + kstep, voffB); PG8_STAGE(PG8_SA(1, 0), cA + kstep, voffA); PG8_STAGE(PG8_SB(1, 1), cB + hstep + kstep, voffB);
        PG8_WAIT_V(6); PG8_BAR;
    } else {
        PG8_STAGE(PG8_SB(0, 0), cB, voffB); PG8_STAGE(PG8_SA(0, 0), cA, voffA); PG8_STAGE(PG8_SB(0, 1), cB + hstep, voffB); PG8_STAGE(PG8_SA(0, 1), cA + hstep, voffA);
        if (wr == 1) PG8_BAR;
        PG8_WAIT_V(4); PG8_BAR;
        PG8_STAGE(PG8_SB(1, 0), cB + kstep, voffB); PG8_STAGE(PG8_SA(1, 0), cA + kstep, voffA); PG8_STAGE(PG8_SB(1, 1), cB + hstep + kstep, voffB);
        PG8_WAIT_V(6); PG8_BAR;
    }
    for (;;) {
        const bool has_next = S.next(ui + 1, nxt);
        const char* nA = has_next ? (const char*)g.A + (size_t)nxt.pm * tstep + (size_t)nxt.ko * 2 : cA; const char* nB = has_next ? (const char*)g.Bt + (size_t)nxt.pn * tstep + (size_t)nxt.ko * 2 : cB;
        for (int t = 0; t < nt; t += 2) {
            const bool last = (t == nt - 2);
            const char* a1 = cA + (size_t)(t + 1) * kstep;
            const char* a2 = last ? nA : cA + (size_t)(t + 2) * kstep; const char* b2 = last ? nB : cB + (size_t)(t + 2) * kstep;
            const char* a3 = a2 + kstep; const char* b3 = b2 + kstep;
            if (last && has_next) S.a_ready(nxt);
            if constexpr (SP2) {
            PG8_LDB(B0, 0, 0); PG8_LDB(B1, 0, 1); PG8_SCHED; PG8_LDA(At, 0, 0); PG8_STAGE(PG8_SA(1, 1), a1 + hstep, voffA);
            PG8_WAIT_V(8); PG8_WAIT_L(0); PG8_BAR; PG8_MMA(0, 0, At, B0); PG8_MMA(0, 1, At, B1); PG8_BAR; PG8_SCHED;
            PG8_LDA(At, 0, 1); PG8_STAGE(PG8_SB(0, 0), b2, voffB); PG8_STAGE(PG8_SB(0, 1), b2 + hstep, voffB); PG8_STAGE(PG8_SA(0, 0), a2, voffA);
            PG8_WAIT_V(8); PG8_WAIT_L(0); PG8_BAR; PG8_MMA(1, 0, At, B0); PG8_MMA(1, 1, At, B1); PG8_BAR; PG8_SCHED;
            PG8_LDB(B0, 1, 0); PG8_LDB(B1, 1, 1); PG8_SCHED; PG8_LDA(At, 1, 0); PG8_STAGE(PG8_SA(0, 1), a2 + hstep, voffA);
            PG8_WAIT_V(8); PG8_WAIT_L(0); PG8_BAR; PG8_MMA(0, 0, At, B0); PG8_MMA(0, 1, At, B1); PG8_BAR; PG8_SCHED;
            PG8_LDA(At, 1, 1); PG8_STAGE(PG8_SB(1, 0), b3, voffB); PG8_STAGE(PG8_SB(1, 1), b3 + hstep, voffB); PG8_STAGE(PG8_SA(1, 0), a3, voffA);
            PG8_WAIT_V(8); PG8_WAIT_L(0); PG8_BAR; PG8_MMA(1, 0, At, B0); PG8_MMA(1, 1, At, B1); PG8_BAR; PG8_SCHED;
            } else {
            PG8_LDB(B0, 0, 0); PG8_SCHED; PG8_LDA(At, 0, 0); PG8_STAGE(PG8_SA(1, 1), a1 + hstep, voffA);
            PG8_WAIT_L(8); PG8_BAR; PG8_WAIT_L(0); PG8_MMA(0, 0, At, B0); PG8_BAR; PG8_SCHED;
            PG8_LDB(B1, 0, 1); PG8_STAGE(PG8_SB(0, 0), b2, voffB);
            PG8_BAR; PG8_WAIT_L(0); PG8_MMA(0, 1, At, B1); PG8_BAR;
            PG8_LDA(At, 0, 1); PG8_STAGE(PG8_SA(0, 0), a2, voffA);
            PG8_BAR; PG8_WAIT_L(0); PG8_MMA(1, 0, At, B0); PG8_BAR; PG8_SCHED;
            PG8_STAGE(PG8_SB(0, 1), b2 + hstep, voffB);
            PG8_WAIT_V(6); PG8_BAR; PG8_MMA(1, 1, At, B1); PG8_BAR;
            PG8_LDB(B0, 1, 0); PG8_SCHED; PG8_LDA(At, 1, 0); PG8_STAGE(PG8_SA(0, 1), a2 + hstep, voffA);
            PG8_WAIT_L(8); PG8_BAR; PG8_WAIT_L(0); PG8_MMA(0, 0, At, B0); PG8_BAR; PG8_SCHED;
            PG8_LDB(B1, 1, 1); PG8_STAGE(PG8_SB(1, 0), b3, voffB);
            PG8_BAR; PG8_WAIT_L(0); PG8_MMA(0, 1, At, B1); PG8_BAR;
            PG8_LDA(At, 1, 1); PG8_STAGE(PG8_SA(1, 0), a3, voffA);
            PG8_BAR; PG8_WAIT_L(0); PG8_MMA(1, 0, At, B0); PG8_BAR; PG8_SCHED;
            PG8_STAGE(PG8_SB(1, 1), b3 + hstep, voffB);
            PG8_WAIT_V(6); PG8_BAR; PG8_MMA(1, 1, At, B1); PG8_BAR;
            }
        }
        if constexpr (ALIGN_EPI) { if (wr == 0) PG8_BAR; }
        if constexpr (!Epi::AFTER_DRAIN) { E(acc, cur, wr, wc, fr, fq); S.done(cur); }
        if (!has_next) break;
#pragma unroll
        for (int a = 0; a < 2; ++a)
#pragma unroll
            for (int b = 0; b < 2; ++b)
#pragma unroll
                for (int m = 0; m < 4; ++m)
#pragma unroll
                    for (int n = 0; n < 2; ++n) acc[a][b][m][n] = (f32x4){0.f, 0.f, 0.f, 0.f};
        cur = nxt; cA = nA; cB = nB; ++ui;
        if constexpr (ALIGN_EPI) { if (wr == 1) PG8_BAR; }
    }
    PG8_WAIT_V(0);
    if constexpr (!ALIGN_EPI) { if (wr == 0) PG8_BAR; }
    PG8_BAR;
    if constexpr (Epi::AFTER_DRAIN) { E.fused(acc, cur, wr, wc, fr, fq, lds, wid, lane); S.done(cur); }
#undef PG8_SA
#undef PG8_SB
#undef PG8_STAGE
#undef PG8_LDA
#undef PG8_LDB
#undef PG8_MMA
#undef PG8_WAIT_V
#undef PG8_WAIT_L
#undef PG8_BAR
#undef PG8_SCHED
}
}


#define GAS __attribute__((address_space(1)))
#define LAS __attribute__((address_space(3)))
typedef unsigned short bf16;
typedef unsigned v4u __attribute__((ext_vector_type(4)));
typedef float f32x4 __attribute__((ext_vector_type(4)));
typedef short bf16x8 __attribute__((ext_vector_type(8)));
typedef GAS unsigned gu32;
typedef GAS unsigned long long gu64;
#define RLX_AGENT __ATOMIC_RELAXED, __HIP_MEMORY_SCOPE_AGENT
#define LDS_WAIT() asm volatile("s_waitcnt lgkmcnt(0)" ::: "memory")
#define VM_WAIT() asm volatile("s_waitcnt vmcnt(0)" ::: "memory")
__device__ __forceinline__ unsigned long long rt() { return __builtin_amdgcn_s_memrealtime(); }
__device__ __forceinline__ unsigned f2bf(float f) { unsigned u = __builtin_bit_cast(unsigned, f); return (u + 0x7fffu + ((u >> 16) & 1u)) >> 16; }
__device__ __forceinline__ unsigned pk2(float lo, float hi) { return f2bf(lo) | (f2bf(hi) << 16); }

#define XB_TMO      128
#define XB_XCNT(j)  (256  + 64 * (j))
#define XB_XSUB(j)  (1280 + 64 * (j))
#define XB_XGEN(j)  (2304 + 64 * (j))
#define XB_TOP      3328
#define XB_TOPGEN   3392
#define XCD_BAR_WORDS 3456
#define XB_SPIN_CAP (1u << 18)

__device__ __forceinline__ unsigned xb_ld(unsigned* p)              { return __hip_atomic_load(p, __ATOMIC_RELAXED, __HIP_MEMORY_SCOPE_AGENT); }
__device__ __forceinline__ unsigned xb_add(unsigned* p, unsigned v) { return __hip_atomic_fetch_add(p, v, __ATOMIC_RELAXED, __HIP_MEMORY_SCOPE_AGENT); }
__device__ __forceinline__ unsigned xb_xcc_id() { return (unsigned)__builtin_amdgcn_s_getreg((3 << 11) | 20) & 0xFu; }
#define XB_SPIN(cond, bar) do { unsigned _sp = 0; while (cond) { __builtin_amdgcn_s_sleep(1); \
    if ((++_sp & 255u) == 0u) { if (xb_ld(&(bar)[XB_TMO])) break; if (_sp > XB_SPIN_CAP) { atomicAdd(&(bar)[XB_TMO], 1u); break; } } } } while (0)

struct XcdBarrier {
    unsigned* bar; unsigned x;
    volatile LAS unsigned* st;
};

__device__ __forceinline__ XcdBarrier xcd_barrier_post(unsigned* bar, volatile LAS unsigned* st) {
    XcdBarrier b; b.bar = bar; b.x = xb_xcc_id(); b.st = st;
    if (threadIdx.x == 0) (void)xb_add(&bar[XB_XCNT(b.x)], 1u);
    return b;
}
__device__ __forceinline__ void xcd_barrier_complete(unsigned* bar, unsigned x, unsigned& nloc, unsigned& nx) {
    const unsigned G = gridDim.x * gridDim.y * gridDim.z;
    unsigned sum, cnt, mine, sp = 0u;
    for (;;) {
        sum = 0u; cnt = 0u; mine = 0u;
#pragma unroll
        for (unsigned j = 0; j < 16; ++j) { const unsigned c = xb_ld(&bar[XB_XCNT(j)]); sum += c; cnt += (c > 0u) ? 1u : 0u; mine = (j == x) ? c : mine; }
        if (sum == G) break;
        __builtin_amdgcn_s_sleep(1);
        if ((++sp & 255u) == 0u) { if (xb_ld(&bar[XB_TMO])) break; if (sp > XB_SPIN_CAP) { atomicAdd(&bar[XB_TMO], 1u); break; } }
    }
    nloc = mine > 0u ? mine : 1u; nx = cnt > 0u ? cnt : 1u;
}

__device__ __forceinline__ void xcd_barrier(const XcdBarrier& b) {
    asm volatile("s_waitcnt vmcnt(0)" ::: "memory");
    __syncthreads();
    if (threadIdx.x == 0) {
        unsigned* bar = b.bar;
        __builtin_amdgcn_s_waitcnt(0);
        unsigned nloc = b.st[0], nx = b.st[1];
        if (nloc == 0u) { xcd_barrier_complete(bar, b.x, nloc, nx); b.st[0] = nloc; b.st[1] = nx; }
        const unsigned old = xb_add(&bar[XB_XSUB(b.x)], 1u);
        const unsigned gen = old / nloc;
        if (old + 1u == (gen + 1u) * nloc) {
            __builtin_amdgcn_fence(__ATOMIC_RELEASE, "agent");
            asm volatile("s_waitcnt vmcnt(0)" ::: "memory");
            const unsigned og = xb_add(&bar[XB_TOP], 1u);
            const unsigned tg = og / nx;
            if (og + 1u == (tg + 1u) * nx) xb_add(&bar[XB_TOPGEN], 1u);
            else XB_SPIN(xb_ld(&bar[XB_TOPGEN]) == tg, bar);
            __builtin_amdgcn_fence(__ATOMIC_ACQUIRE, "agent");
            xb_add(&bar[XB_XGEN(b.x)], 1u);
            asm volatile("s_waitcnt vmcnt(0)" ::: "memory");
        } else {
            XB_SPIN(xb_ld(&bar[XB_XGEN(b.x)]) == gen, bar);
            __builtin_amdgcn_fence(__ATOMIC_ACQUIRE, "agent");
            asm volatile("s_waitcnt vmcnt(0)" ::: "memory");
        }
    }
    __syncthreads();
}


constexpr int DM = 1024, TP = 8192, NBP = 2, MP = NBP * TP, NBS = 128, TS = 4, MS = NBS * TS, M = MP + MS;
constexpr int SBH = 8, SBD = 64, SBDIM = 512, GH = 4, GD = 128, GDIM = 512, CONVD = 1536, FF = 4096;
constexpr int PAST = 2048, PAGE = 128, NPAGES = 16;
constexpr int INW = 5640, NIN = 5632;
constexpr float NORM_EPS = 1e-6f, L2_EPS = 1e-6f, LOG2E = 1.4426950408889634f, QSCALE = 0.125f * 1.4426950408889634f;
constexpr int NWAVES = 8, NTHR = 512;

constexpr size_t O_Y = 0, O_KP = (size_t)M * DM, O_VP = O_KP + (size_t)MP * 512, O_KS = O_VP + (size_t)MP * 512, O_VS = O_KS + (size_t)MS * 512,
    O_CP = O_VS + (size_t)MS * 512, O_CS = O_CP + (size_t)NBP * 3 * CONVD, O_SP = O_CS + (size_t)NBS * 3 * CONVD, O_SS = O_SP + (size_t)NBP * GH * GD * GD,
    O_END = O_SS + (size_t)NBS * GH * GD * GD;
static_assert(O_END == 43721728, "output size");

constexpr size_t MiB = 1u << 20;
constexpr size_t WS_CTL = 0, CTL_ZERO_BYTES = 1 * MiB;
constexpr size_t WS_WIN = 2 * MiB, WS_WCAT = 14 * MiB, WS_WO = 16 * MiB, WS_WUP = 18 * MiB, WS_WDN = 26 * MiB;
constexpr size_t WS_AB = 34 * MiB, WS_GBETA = 35 * MiB, WS_XN = 36 * MiB, WS_QA = 69 * MiB, WS_KA = 86 * MiB, WS_VA = 103 * MiB, WS_U = 120 * MiB;
constexpr size_t WS_ZB = 219 * MiB, WS_GA = 236 * MiB, WS_GB = 269 * MiB, WS_OCAT = 302 * MiB, WS_TMP = 335 * MiB, WS_MB = 401 * MiB, WS_X1 = 434 * MiB, WS_X1B = 500 * MiB;
constexpr size_t WS_H = 533 * MiB, WS_QKVN = 665 * MiB, WS_ORAW = 764 * MiB, WS_END = 800 * MiB;
constexpr int CW_TMO = 0, CW_CODE = 1, CW_BAR = 4096, CW_SS1 = 65536, CW_SS2 = 98304;
static_assert((CW_SS2 + M) * 4 <= (int)CTL_ZERO_BYTES, "control words inside the memset region");

constexpr int RING_OFF = 0, RING_BYTES = 131072, LDSCTL_OFF = RING_BYTES, MISC_OFF = LDSCTL_OFF + 320, LDS_BYTES = 147456;

__device__ __forceinline__ float bf2f(bf16 b) { return __uint_as_float((unsigned)b << 16); }
__device__ __forceinline__ float wave_sum(float v) {
#pragma unroll
    for (int o = 1; o < 64; o <<= 1) v += __shfl_xor(v, o);
    return v;
}
__device__ __forceinline__ float sigmoidf_(float x) { return __builtin_amdgcn_rcpf(1.f + __expf(-x)); }

struct Frame {
    LAS unsigned char* lds;
    volatile LAS unsigned* MISC;
    gu32* ctl;
    int tid, lane, wave, vcu, G;
    const float *xp, *xs, *cache_k, *cache_v, *state_conv, *state_ssm, *norm_mix_w, *w_in, *sb_bias, *conv_w, *a_log, *dt_bias, *gdn_norm_w, *w_pa, *w_pb, *w_o, *norm_mlp_w, *w_up, *w_down, *norm_final_w;
    const int* page_table;
    float* out; unsigned char* ws;
};
#define WSP(T, off) ((T*)(F.ws + (off)))

struct StaticOrder {
    int nM, nN, nwg, G, c;
    __device__ void init(int M_, int N_, int G_, int c_) { nM = M_ / pg8::BM; nN = N_ / pg8::BM; nwg = nM * nN; G = G_; c = c_; }
    __device__ bool next(int i, pg8::Unit& u) const {
        const long L = (long)i * G + c; if (L >= nwg) return false;
        int wgid = (int)L; { const int q = nwg / pg8::NXCD, r = nwg % pg8::NXCD, xcd = wgid % pg8::NXCD, off = wgid / pg8::NXCD; wgid = (xcd < r ? xcd * (q + 1) : r * (q + 1) + (xcd - r) * q) + off; }
        const int nig = pg8::WGM * nN, gid = wgid / nig, fm = gid * pg8::WGM, gsz = (nM - fm) < pg8::WGM ? (nM - fm) : pg8::WGM;
        u.pm = fm + ((wgid % nig) % gsz); u.pn = (wgid % nig) / gsz; u.ko = 0; return true;
    }
    __device__ __forceinline__ void a_ready(const pg8::Unit&) const {}
    __device__ __forceinline__ void done(const pg8::Unit&) const {}
};
struct MergeOrder {
    int G, c, ntile;
    __device__ bool next(int i, pg8::Unit& u) const { const int t = (i >> 1) * G + c; if (t >= ntile) return false; u.pm = t >> 2; u.pn = t & 3; u.ko = (i & 1) * 512; return true; }
    __device__ __forceinline__ void a_ready(const pg8::Unit&) const {}
    __device__ __forceinline__ void done(const pg8::Unit&) const {}
};

typedef pg8::f32x4 a4;
#define EPI_LOOP_BEGIN const int row0 = u.pm * 256 + wr * 64 + fr; const int cw = wc * 32 + 8 * fq; \
    _Pragma("unroll") for (int ai = 0; ai < 2; ++ai) _Pragma("unroll") for (int m = 0; m < 4; ++m) { const int row = row0 + ai * 128 + m * 16; \
    _Pragma("unroll") for (int bj = 0; bj < 2; ++bj) { const int col = u.pn * 256 + bj * 128 + cw; a4 v0 = acc[ai][bj][m][0], v1 = acc[ai][bj][m][1];
#define EPI_LOOP_END } }
__device__ __forceinline__ v4u pack8(a4 v0, a4 v1) { v4u w; w.x = pg8::cvt_pk_bf16(v0[0], v0[1]); w.y = pg8::cvt_pk_bf16(v0[2], v0[3]); w.z = pg8::cvt_pk_bf16(v1[0], v1[1]); w.w = pg8::cvt_pk_bf16(v1[2], v1[3]); return w; }
__device__ __forceinline__ void unpack8(v4u w, a4& v0, a4& v1) {
    v0[0] = __uint_as_float(w.x << 16); v0[1] = __uint_as_float(w.x & 0xffff0000u); v0[2] = __uint_as_float(w.y << 16); v0[3] = __uint_as_float(w.y & 0xffff0000u);
    v1[0] = __uint_as_float(w.z << 16); v1[1] = __uint_as_float(w.z & 0xffff0000u); v1[2] = __uint_as_float(w.w << 16); v1[3] = __uint_as_float(w.w & 0xffff0000u); }

struct EpiIn {
    static constexpr bool PERM = true, AFTER_DRAIN = false;
    bf16 *Qa, *Ka, *Va, *Zb, *GA, *GB; float* U; float* out;
    __device__ __forceinline__ void operator()(const a4 (&acc)[2][2][4][2], const pg8::Unit& u, int wr, int wc, int fr, int fq) const {
        const int pn = u.pn;
        EPI_LOOP_BEGIN
            if (pn < 2) { *(v4u*)(Qa + (size_t)row * 512 + col) = pack8(v0 * QSCALE, v1 * QSCALE); }
            else if (pn < 6) { const bool isk = pn < 4; const int cc = col - (isk ? 512 : 1024);
                float* o = out + (row < MP ? (isk ? O_KP : O_VP) + (size_t)row * 512 : (isk ? O_KS : O_VS) + (size_t)(row - MP) * 512) + cc;
                *(a4*)o = v0; *(a4*)(o + 4) = v1; *(v4u*)((isk ? Ka : Va) + (size_t)row * 512 + cc) = pack8(v0, v1); }
            else if (pn < 12) { float* o = U + (size_t)row * CONVD + (col - 1536); *(a4*)o = v0; *(a4*)(o + 4) = v1; }
            else if (pn < 14) { *(v4u*)(Zb + (size_t)row * 512 + (col - 3072)) = pack8(v0, v1); }
            else { const bool isa = pn < 18; const int cc = col - (isa ? 3584 : 4608);
#pragma unroll
                for (int e = 0; e < 4; ++e) { v0[e] = sigmoidf_(v0[e]); v1[e] = sigmoidf_(v1[e]); }
                *(v4u*)((isa ? GA : GB) + (size_t)row * DM + cc) = pack8(v0, v1); }
        EPI_LOOP_END
    }
};
struct EpiMerge {
    static constexpr bool PERM = true, AFTER_DRAIN = false;
    const bf16 *GA, *GB; float* TMP; bf16* Mb;
    __device__ __forceinline__ void operator()(const a4 (&acc)[2][2][4][2], const pg8::Unit& u, int wr, int wc, int fr, int fq) const {
        const bool second = u.ko != 0;
        EPI_LOOP_BEGIN
            const size_t idx = (size_t)row * DM + col; a4 g0, g1; unpack8(*(const v4u*)((second ? GB : GA) + idx), g0, g1);
            if (!second) { *(a4*)(TMP + idx) = v0 * g0; *(a4*)(TMP + idx + 4) = v1 * g1; }
            else { const a4 t0 = *(const a4*)(TMP + idx), t1 = *(const a4*)(TMP + idx + 4); *(v4u*)(Mb + idx) = pack8(t0 + v0 * g0, t1 + v1 * g1); }
        EPI_LOOP_END
    }
};
struct EpiRes {
    static constexpr bool PERM = true, AFTER_DRAIN = false;
    const float *baseP, *baseS; float* Rf; bf16* Rb; float* SS;
    __device__ __forceinline__ void operator()(const a4 (&acc)[2][2][4][2], const pg8::Unit& u, int wr, int wc, int fr, int fq) const {
        float ss[2][4];
#pragma unroll
        for (int a = 0; a < 2; ++a)
#pragma unroll
            for (int b = 0; b < 4; ++b) ss[a][b] = 0.f;
        EPI_LOOP_BEGIN
            const float* bp = (row < MP ? baseP + (size_t)row * DM : baseS + (size_t)(row - MP) * DM) + col;
            const a4 r0 = *(const a4*)bp + v0, r1 = *(const a4*)(bp + 4) + v1; const size_t idx = (size_t)row * DM + col;
            *(a4*)(Rf + idx) = r0; *(a4*)(Rf + idx + 4) = r1; if (Rb) *(v4u*)(Rb + idx) = pack8(r0, r1);
            ss[ai][m] += (r0[0] * r0[0] + r0[1] * r0[1]) + (r0[2] * r0[2] + r0[3] * r0[3]) + (r1[0] * r1[0] + r1[1] * r1[1]) + (r1[2] * r1[2] + r1[3] * r1[3]);
        EPI_LOOP_END
#pragma unroll
        for (int ai = 0; ai < 2; ++ai)
#pragma unroll
            for (int m = 0; m < 4; ++m) { float s = ss[ai][m]; s += __shfl_xor(s, 16); s += __shfl_xor(s, 32);
                if (fq == 0) __hip_atomic_fetch_add(SS + (u.pm * 256 + wr * 64 + fr + ai * 128 + m * 16), s, __ATOMIC_RELAXED, __HIP_MEMORY_SCOPE_AGENT); }
    }
};
struct EpiUp {
    static constexpr bool PERM = true, AFTER_DRAIN = false;
    const float* SS; bf16* H;
    __device__ __forceinline__ void operator()(const a4 (&acc)[2][2][4][2], const pg8::Unit& u, int wr, int wc, int fr, int fq) const {
        EPI_LOOP_BEGIN
            const float rs = __builtin_amdgcn_rsqf(__hip_atomic_load(SS + row, __ATOMIC_RELAXED, __HIP_MEMORY_SCOPE_AGENT) * (1.f / DM) + NORM_EPS);
#pragma unroll
            for (int e = 0; e < 4; ++e) { float a = fmaxf(v0[e] * rs, 0.f), b = fmaxf(v1[e] * rs, 0.f); v0[e] = a * a; v1[e] = b * b; }
            *(v4u*)(H + (size_t)row * FF + col) = pack8(v0, v1);
        EPI_LOOP_END
    }
};

__device__ __forceinline__ void p0_transpose_item(const float* W, int ldw, int nblk, bf16* WT, int ldt, int koff, const float* kscale, int shift_from, int shift, LAS float* scr, int item, int lane) {
    const int kb = item / nblk, nb = item % nblk, k0 = 64 * kb, n0 = 32 * nb, ns = n0 + (n0 >= shift_from ? shift : 0);
#pragma unroll 8
    for (int i = 0; i < 32; ++i) { const int kk = 2 * i + (lane >> 5); float w = W[(size_t)(k0 + kk) * ldw + ns + (lane & 31)]; if (kscale) w *= kscale[k0 + kk]; scr[kk * 33 + (lane & 31)] = w; }
    LDS_WAIT(); asm volatile("" ::: "memory");
    const int c = lane & 7;
#pragma unroll
    for (int j = 0; j < 4; ++j) { const int n = (lane >> 3) + 8 * j; const LAS float* s = scr + (8 * c) * 33 + n;
        v4u o; o.x = pk2(s[0 * 33], s[1 * 33]); o.y = pk2(s[2 * 33], s[3 * 33]); o.z = pk2(s[4 * 33], s[5 * 33]); o.w = pk2(s[6 * 33], s[7 * 33]);
        *(GAS v4u*)(WT + (size_t)(n0 + n) * ldt + koff + k0 + 8 * c) = o; }
    LDS_WAIT(); asm volatile("" ::: "memory");
}
__device__ __forceinline__ void p0_prologue(Frame& F) {
    LAS float* scr = (LAS float*)(F.lds + RING_OFF + F.wave * 16384);
    const int gw = F.vcu * NWAVES + F.wave, NGW = F.G * NWAVES, lane = F.lane;
    constexpr int I_IN = (DM / 64) * (NIN / 32), I_PA = (512 / 64) * (DM / 32), I_O = (DM / 64) * (DM / 32), I_UP = (DM / 64) * (FF / 32), I_DN = (FF / 64) * (DM / 32);
    constexpr int NITEMS = I_IN + 2 * I_PA + I_O + I_UP + I_DN;
    for (int it = gw; it < NITEMS; it += NGW) {
        int r = it;
        if (r < I_IN) { p0_transpose_item(F.w_in, INW, NIN / 32, WSP(bf16, WS_WIN), DM, 0, F.norm_mix_w, 3584, 8, scr, r, lane); continue; } r -= I_IN;
        if (r < I_PA) { p0_transpose_item(F.w_pa, DM, DM / 32, WSP(bf16, WS_WCAT), DM, 0, nullptr, 1 << 30, 0, scr, r, lane); continue; } r -= I_PA;
        if (r < I_PA) { p0_transpose_item(F.w_pb, DM, DM / 32, WSP(bf16, WS_WCAT), DM, 512, nullptr, 1 << 30, 0, scr, r, lane); continue; } r -= I_PA;
        if (r < I_O) { p0_transpose_item(F.w_o, DM, DM / 32, WSP(bf16, WS_WO), DM, 0, nullptr, 1 << 30, 0, scr, r, lane); continue; } r -= I_O;
        if (r < I_UP) { p0_transpose_item(F.w_up, FF, FF / 32, WSP(bf16, WS_WUP), DM, 0, F.norm_mlp_w, 1 << 30, 0, scr, r, lane); continue; } r -= I_UP;
        p0_transpose_item(F.w_down, DM, DM / 32, WSP(bf16, WS_WDN), FF, 0, nullptr, 1 << 30, 0, scr, r, lane);
    }
    f32x4 wab[4][4][2];
#pragma unroll
    for (int jj = 0; jj < 4; ++jj)
#pragma unroll
        for (int e = 0; e < 4; ++e) { const int k = 256 * jj + 4 * lane + e; const float nw = F.norm_mix_w[k]; const float* wp = F.w_in + (size_t)k * INW + 3584;
            wab[jj][e][0] = *(const f32x4*)wp * nw; wab[jj][e][1] = *(const f32x4*)(wp + 4) * nw; }
    bf16* XN = WSP(bf16, WS_XN); float* AB = WSP(float, WS_AB);
    for (int m = gw; m < M; m += NGW) {
        const float* xrow = m < MP ? F.xp + (size_t)m * DM : F.xs + (size_t)(m - MP) * DM;
        const GAS f32x4* xr = (const GAS f32x4*)xrow + lane;
        f32x4 v[4]; float s = 0.f;
#pragma unroll
        for (int j = 0; j < 4; ++j) { v[j] = xr[64 * j]; s += (v[j].x * v[j].x + v[j].y * v[j].y) + (v[j].z * v[j].z + v[j].w * v[j].w); }
        const float rstd = 1.f / sqrtf(wave_sum(s) * (1.f / DM) + NORM_EPS);
        GAS unsigned long long* o8 = (GAS unsigned long long*)(XN + (size_t)m * DM) + lane;
        f32x4 d0 = {0.f, 0.f, 0.f, 0.f}, d1 = {0.f, 0.f, 0.f, 0.f};
#pragma unroll
        for (int j = 0; j < 4; ++j) { v[j] = v[j] * rstd;
            o8[64 * j] = (unsigned long long)pk2(v[j].x, v[j].y) | ((unsigned long long)pk2(v[j].z, v[j].w) << 32);
#pragma unroll
            for (int e = 0; e < 4; ++e) { d0 += wab[j][e][0] * v[j][e]; d1 += wab[j][e][1] * v[j][e]; } }
#pragma unroll
        for (int e = 0; e < 4; ++e) { d0[e] = wave_sum(d0[e]); d1[e] = wave_sum(d1[e]); }
        if (lane == 0) { *(f32x4*)(AB + (size_t)m * 8) = d0; *(f32x4*)(AB + (size_t)m * 8 + 4) = d1; }
    }
}

__device__ __forceinline__ void p2_gdn_prep(Frame& F) {
    const int gw = F.vcu * NWAVES + F.wave, NGW = F.G * NWAVES, lane = F.lane;
    const float* U = WSP(float, WS_U); float* QKVN = WSP(float, WS_QKVN); const float* AB = WSP(float, WS_AB); float* GBETA = WSP(float, WS_GBETA);
    typedef float f2 __attribute__((ext_vector_type(2)));
    for (int it = gw; it < M * GH; it += NGW) {
        const int row = it >> 2, h = it & 3;
        int t, seq; bool prompt = row < MP; if (prompt) { seq = row / TP; t = row % TP; } else { seq = (row - MP) >> 2; t = (row - MP) & 3; }
        f2 cv[3];
#pragma unroll
        for (int p = 0; p < 3; ++p) {
            const int ch = p * 512 + h * 128 + 2 * lane; f2 acc = {0.f, 0.f};
#pragma unroll
            for (int w = 0; w < 4; ++w) {
                const int tt = t - 3 + w; f2 uv;
                if (tt >= 0) uv = *(const f2*)(U + (size_t)(row - 3 + w) * CONVD + ch);
                else if (prompt) uv = (f2){0.f, 0.f};
                else uv = *(const f2*)(F.state_conv + ((size_t)seq * 3 + (tt + 3)) * CONVD + ch);
                const f2 cw = *(const f2*)(F.conv_w + (size_t)w * CONVD + ch);
                acc += uv * cw;
            }
            acc.x = acc.x * sigmoidf_(acc.x); acc.y = acc.y * sigmoidf_(acc.y);
            cv[p] = acc;
            const int tl = prompt ? TP : TS;
            if (t >= tl - 3) { const f2 uv = *(const f2*)(U + (size_t)row * CONVD + ch); const int i = t - (tl - 3);
                float* o = F.out + (prompt ? O_CP + ((size_t)seq * 3 + i) * CONVD : O_CS + ((size_t)seq * 3 + i) * CONVD) + ch; *(f2*)o = uv; }
        }
        const float sq = wave_sum(cv[0].x * cv[0].x + cv[0].y * cv[0].y), sk = wave_sum(cv[1].x * cv[1].x + cv[1].y * cv[1].y);
        const float rq = __builtin_amdgcn_rsqf(sq + L2_EPS) * 0.08838834764831845f, rk = __builtin_amdgcn_rsqf(sk + L2_EPS);
        float* o = QKVN + (size_t)row * CONVD + h * 128 + 2 * lane;
        *(f2*)o = cv[0] * rq; *(f2*)(o + 512) = cv[1] * rk; *(f2*)(o + 1024) = cv[2];
        if (lane == 0) { const float a = AB[(size_t)row * 8 + h] + F.dt_bias[h], b = AB[(size_t)row * 8 + 4 + h];
            const float sp = a > 20.f ? a : log1pf(__expf(a));
            GBETA[(size_t)row * 8 + h] = -__expf(F.a_log[h]) * sp; GBETA[(size_t)row * 8 + 4 + h] = sigmoidf_(b); }
    }
}

__device__ __forceinline__ void p3_attn_naive(Frame& F) {
    const bf16* Qa = WSP(bf16, WS_QA); bf16* Ocat = WSP(bf16, WS_OCAT);
    LAS float* Ks = (LAS float*)(F.lds + RING_OFF); LAS float* Vs = Ks + 8192;
    const int tid = F.tid;
    for (int un = F.vcu; un < NBP * SBH * (TP / 512); un += F.G) {
        const int qb = (TP / 512 - 1) - (un / (NBP * SBH)), bh = un % (NBP * SBH), b = bh / SBH, h = bh % SBH;
        const int t = qb * 512 + tid; const size_t row = (size_t)b * TP + t;
        const float bias2 = F.sb_bias[h] * LOG2E;
        float q[64], o[64];
#pragma unroll
        for (int d = 0; d < 64; d += 8) { a4 v0, v1; unpack8(*(const v4u*)(Qa + row * 512 + h * 64 + d), v0, v1);
#pragma unroll
            for (int e = 0; e < 4; ++e) { q[d + e] = v0[e]; q[d + 4 + e] = v1[e]; } }
#pragma unroll
        for (int d = 0; d < 64; ++d) o[d] = 0.f;
        float prod = 1.f;
        const float* Kg = F.out + O_KP + (size_t)b * TP * 512 + h * 64; const float* Vg = F.out + O_VP + (size_t)b * TP * 512 + h * 64;
        for (int kt = qb * 8 + 7; kt >= 0; --kt) {
            __syncthreads();
#pragma unroll
            for (int i = 0; i < 2; ++i) { const int f = tid + i * 512, r = f >> 4, c4 = (f & 15) * 4;
                *(LAS a4*)(Ks + r * 64 + c4) = *(const a4*)(Kg + (size_t)(kt * 64 + r) * 512 + c4);
                *(LAS a4*)(Vs + r * 64 + c4) = *(const a4*)(Vg + (size_t)(kt * 64 + r) * 512 + c4); }
            __syncthreads();
            for (int s = 63; s >= 0; --s) {
                const int kp = kt * 64 + s;
                float z = bias2;
#pragma unroll
                for (int d = 0; d < 64; d += 4) { const a4 kv = *(const LAS a4*)(Ks + s * 64 + d); z += q[d] * kv[0] + q[d + 1] * kv[1] + q[d + 2] * kv[2] + q[d + 3] * kv[3]; }
                const float e = __builtin_amdgcn_exp2f(z), r = __builtin_amdgcn_rcpf(1.f + e);
                const float w = (kp < t) ? e * r * prod : 0.f;
                if (kp < t) prod *= r;
#pragma unroll
                for (int d = 0; d < 64; d += 4) { const a4 vv = *(const LAS a4*)(Vs + s * 64 + d); o[d] += w * vv[0]; o[d + 1] += w * vv[1]; o[d + 2] += w * vv[2]; o[d + 3] += w * vv[3]; }
            }
        }
#pragma unroll
        for (int d = 0; d < 64; d += 8) { a4 v0 = {o[d], o[d + 1], o[d + 2], o[d + 3]}, v1 = {o[d + 4], o[d + 5], o[d + 6], o[d + 7]}; *(v4u*)(Ocat + row * DM + h * 64 + d) = pack8(v0, v1); }
    }
    for (int sq = F.vcu; sq < NBS; sq += F.G) {
        const int h = (tid >> 2) & 7, j = tid & 3; const size_t row = (size_t)MP + sq * 4 + j;
        const float bias2 = F.sb_bias[h] * LOG2E;
        float q[64], o[64];
#pragma unroll
        for (int d = 0; d < 64; d += 8) { a4 v0, v1; unpack8(*(const v4u*)(Qa + row * 512 + h * 64 + d), v0, v1);
#pragma unroll
            for (int e = 0; e < 4; ++e) { q[d + e] = v0[e]; q[d + 4 + e] = v1[e]; } }
#pragma unroll
        for (int d = 0; d < 64; ++d) o[d] = 0.f;
        float prod = 1.f;
        for (int kt = 128; kt >= 0; --kt) {
            __syncthreads();
#pragma unroll
            for (int i = 0; i < 4; ++i) { const int f = tid + i * 512, r = f >> 7, c4 = (f & 127) * 4;
                const float *kp, *vp; bool ok = true;
                if (kt == 128) { ok = r < 4; kp = F.out + O_KS + (size_t)(sq * 4 + (r & 3)) * 512 + c4; vp = F.out + O_VS + (size_t)(sq * 4 + (r & 3)) * 512 + c4; }
                else { const int key = kt * 16 + r, pg = F.page_table[sq * NPAGES + (key >> 7)]; const size_t off = ((size_t)pg * PAGE + (key & 127)) * 512 + c4; kp = F.cache_k + off; vp = F.cache_v + off; }
                if (ok) { *(LAS a4*)(Ks + r * 512 + c4) = *(const a4*)kp; *(LAS a4*)(Vs + r * 512 + c4) = *(const a4*)vp; } }
            __syncthreads();
            if (tid < 32) {
                for (int s = (kt == 128 ? 3 : 15); s >= 0; --s) {
                    const bool valid = (kt < 128) || (s < j);
                    float z = bias2;
#pragma unroll
                    for (int d = 0; d < 64; d += 4) { const a4 kv = *(const LAS a4*)(Ks + s * 512 + h * 64 + d); z += q[d] * kv[0] + q[d + 1] * kv[1] + q[d + 2] * kv[2] + q[d + 3] * kv[3]; }
                    const float e = __builtin_amdgcn_exp2f(z), r = __builtin_amdgcn_rcpf(1.f + e);
                    const float w = valid ? e * r * prod : 0.f;
                    if (valid) prod *= r;
#pragma unroll
                    for (int d = 0; d < 64; d += 4) { const a4 vv = *(const LAS a4*)(Vs + s * 512 + h * 64 + d); o[d] += w * vv[0]; o[d + 1] += w * vv[1]; o[d + 2] += w * vv[2]; o[d + 3] += w * vv[3]; }
                }
            }
        }
        if (tid < 32) {
#pragma unroll
            for (int d = 0; d < 64; d += 8) { a4 v0 = {o[d], o[d + 1], o[d + 2], o[d + 3]}, v1 = {o[d + 4], o[d + 5], o[d + 6], o[d + 7]}; *(v4u*)(Ocat + row * DM + h * 64 + d) = pack8(v0, v1); }
        }
    }
    __syncthreads();
}

__device__ __forceinline__ void p4_gdn_naive(Frame& F) {
    const float* QKVN = WSP(float, WS_QKVN); const float* GBETA = WSP(float, WS_GBETA); float* ORAW = WSP(float, WS_ORAW);
    LAS float* Ls = (LAS float*)(F.lds + RING_OFF);
    const int tid = F.tid, c = tid >> 2, rq = tid & 3;
    for (int un = F.vcu; un < NBP * GH + NBS * GH; un += F.G) {
        const bool prompt = un < NBP * GH; int seq, h, T; size_t row0; const float* s0; float* sout;
        if (prompt) { seq = un / GH; h = un % GH; T = TP; row0 = (size_t)seq * TP; s0 = nullptr; sout = F.out + O_SP + (size_t)(seq * GH + h) * GD * GD; }
        else { const int v = un - NBP * GH; seq = v / GH; h = v % GH; T = TS; row0 = (size_t)MP + seq * TS; s0 = F.state_ssm + (size_t)(seq * GH + h) * GD * GD; sout = F.out + O_SS + (size_t)(seq * GH + h) * GD * GD; }
        float S[32];
#pragma unroll
        for (int i = 0; i < 32; ++i) S[i] = s0 ? s0[(size_t)(rq * 32 + i) * GD + c] : 0.f;
        for (int t0 = 0; t0 < T; t0 += 16) {
            const int nt = (T - t0) < 16 ? (T - t0) : 16;
            __syncthreads();
            for (int f = tid; f < nt * 96; f += NTHR) { const int r = f / 96, q4 = f % 96, part = q4 / 32, c4 = (q4 % 32) * 4;
                *(LAS a4*)(Ls + r * 384 + part * 128 + c4) = *(const a4*)(QKVN + (row0 + t0 + r) * CONVD + part * 512 + h * 128 + c4); }
            if (tid < nt) { Ls[6144 + 2 * tid] = GBETA[(row0 + t0 + tid) * 8 + h]; Ls[6144 + 2 * tid + 1] = GBETA[(row0 + t0 + tid) * 8 + 4 + h]; }
            __syncthreads();
            for (int r = 0; r < nt; ++r) {
                const LAS float* qv = Ls + r * 384 + rq * 32; const LAS float* kv = qv + 128; const float vv = Ls[r * 384 + 256 + c];
                const float eg = __expf(Ls[6144 + 2 * r]), beta = Ls[6144 + 2 * r + 1];
                float kk[32]; float ks = 0.f;
#pragma unroll
                for (int i = 0; i < 32; i += 4) { const a4 k4 = *(const LAS a4*)(kv + i); kk[i] = k4[0]; kk[i + 1] = k4[1]; kk[i + 2] = k4[2]; kk[i + 3] = k4[3]; }
#pragma unroll
                for (int i = 0; i < 32; ++i) ks += kk[i] * S[i];
                ks += __shfl_xor(ks, 1); ks += __shfl_xor(ks, 2);
                const float vn = beta * (vv - eg * ks);
                float os = 0.f;
#pragma unroll
                for (int i = 0; i < 32; i += 4) { const a4 q4 = *(const LAS a4*)(qv + i);
#pragma unroll
                    for (int e = 0; e < 4; ++e) { S[i + e] = eg * S[i + e] + kk[i + e] * vn; os += q4[e] * S[i + e]; } }
                os += __shfl_xor(os, 1); os += __shfl_xor(os, 2);
                if (rq == 0) ORAW[(row0 + t0 + r) * GDIM + h * 128 + c] = os;
            }
        }
#pragma unroll
        for (int i = 0; i < 32; ++i) sout[(size_t)(rq * 32 + i) * GD + c] = S[i];
    }
    __syncthreads();
}

__device__ __forceinline__ void p5_gdn_post(Frame& F) {
    const int gw = F.vcu * NWAVES + F.wave, NGW = F.G * NWAVES, lane = F.lane;
    const float* ORAW = WSP(float, WS_ORAW); const bf16* Zb = WSP(bf16, WS_ZB); bf16* Ocat = WSP(bf16, WS_OCAT);
    for (int it = gw; it < M * GH; it += NGW) {
        const int row = it >> 2, h = it & 3; const size_t ix = (size_t)row * GDIM + h * 128 + 2 * lane;
        const float o0 = ORAW[ix], o1 = ORAW[ix + 1];
        const float rs = __builtin_amdgcn_rsqf(wave_sum(o0 * o0 + o1 * o1) * (1.f / GD) + NORM_EPS);
        const unsigned zz = *(const unsigned*)(Zb + ix); const float z0 = __uint_as_float(zz << 16), z1 = __uint_as_float(zz & 0xffff0000u);
        const float r0 = o0 * rs * F.gdn_norm_w[2 * lane] * (z0 * sigmoidf_(z0)), r1 = o1 * rs * F.gdn_norm_w[2 * lane + 1] * (z1 * sigmoidf_(z1));
        *(unsigned*)(Ocat + (size_t)row * DM + 512 + h * 128 + 2 * lane) = pk2(r0, r1);
    }
}

__device__ __forceinline__ void p10_final(Frame& F) {
    const int gw = F.vcu * NWAVES + F.wave, NGW = F.G * NWAVES, lane = F.lane;
    const float* SS2 = (const float*)(F.ctl + CW_SS2);
    f32x4 nw[4];
#pragma unroll
    for (int j = 0; j < 4; ++j) nw[j] = *((const f32x4*)F.norm_final_w + lane + 64 * j);
    for (int m = gw; m < M; m += NGW) {
        const float rs = __builtin_amdgcn_rsqf(__hip_atomic_load(SS2 + m, __ATOMIC_RELAXED, __HIP_MEMORY_SCOPE_AGENT) * (1.f / DM) + NORM_EPS);
        GAS f32x4* yr = (GAS f32x4*)(F.out + O_Y + (size_t)m * DM) + lane;
#pragma unroll
        for (int j = 0; j < 4; ++j) yr[64 * j] = yr[64 * j] * rs * nw[j];
    }
}

constexpr int N_PHASES = 11;
struct Args { const void* in[21]; float* out; unsigned char* ws; int ph_lo, ph_hi; };
__global__ void __launch_bounds__(NTHR, 2) mk_fwd(Args args) {
    extern __shared__ __attribute__((aligned(16))) unsigned char lds[];
    Frame F;
    F.lds = (LAS unsigned char*)lds; F.MISC = (volatile LAS unsigned*)(F.lds + MISC_OFF);
    F.tid = threadIdx.x; F.lane = F.tid & 63; F.wave = __builtin_amdgcn_readfirstlane(F.tid >> 6);
    F.G = gridDim.x; { const int bx = blockIdx.x; F.vcu = (F.G % 8 == 0) ? (bx % 8) * (F.G / 8) + bx / 8 : bx; }
    F.ws = args.ws; F.out = args.out; F.ctl = (gu32*)(args.ws + WS_CTL);
    F.xp = (const float*)args.in[0]; F.xs = (const float*)args.in[1]; F.cache_k = (const float*)args.in[2]; F.cache_v = (const float*)args.in[3]; F.page_table = (const int*)args.in[4];
    F.state_conv = (const float*)args.in[5]; F.state_ssm = (const float*)args.in[6]; F.norm_mix_w = (const float*)args.in[7]; F.w_in = (const float*)args.in[8]; F.sb_bias = (const float*)args.in[9];
    F.conv_w = (const float*)args.in[10]; F.a_log = (const float*)args.in[11]; F.dt_bias = (const float*)args.in[12]; F.gdn_norm_w = (const float*)args.in[13]; F.w_pa = (const float*)args.in[14];
    F.w_pb = (const float*)args.in[15]; F.w_o = (const float*)args.in[16]; F.norm_mlp_w = (const float*)args.in[17]; F.w_up = (const float*)args.in[18]; F.w_down = (const float*)args.in[19];
    F.norm_final_w = (const float*)args.in[20];
    for (int u = F.tid; u < (LDS_BYTES - LDSCTL_OFF) / 4; u += NTHR) ((LAS unsigned*)(F.lds + LDSCTL_OFF))[u] = 0u;
    __syncthreads();
    const int lo = args.ph_lo, hi = args.ph_hi;
    XcdBarrier bar; bar.bar = (unsigned*)(F.ctl + CW_BAR); bar.x = 0; bar.st = nullptr;
    if (hi - lo > 1) bar = xcd_barrier_post((unsigned*)(F.ctl + CW_BAR), F.MISC + 8);
#define IN(k) (lo <= (k) && (k) < hi)
#define SEAM(k) do { if (IN(k) && IN((k) + 1)) xcd_barrier(bar); } while (0)
    LAS unsigned char* ring = F.lds + RING_OFF;

    if (IN(0)) { p0_prologue(F); } SEAM(0);
    if (IN(1)) {
        pg8::Gemm g{WSP(bf16, WS_XN), WSP(bf16, WS_WIN), M, NIN, DM, DM}; StaticOrder S; S.init(M, NIN, F.G, (int)blockIdx.x);
        EpiIn E{WSP(bf16, WS_QA), WSP(bf16, WS_KA), WSP(bf16, WS_VA), WSP(bf16, WS_ZB), WSP(bf16, WS_GA), WSP(bf16, WS_GB), WSP(float, WS_U), F.out};
        pg8::gemm_phase<EpiIn, StaticOrder, true, true>(ring, g, S, E);
    } SEAM(1);
    if (IN(2)) { p2_gdn_prep(F); } SEAM(2);
    if (IN(3)) { p3_attn_naive(F); } SEAM(3);
    if (IN(4)) { p4_gdn_naive(F); } SEAM(4);
    if (IN(5)) { p5_gdn_post(F); } SEAM(5);
    if (IN(6)) {
        pg8::Gemm g{WSP(bf16, WS_OCAT), WSP(bf16, WS_WCAT), M, DM, 512, DM}; MergeOrder S{F.G, (int)blockIdx.x, (M / 256) * 4};
        EpiMerge E{WSP(bf16, WS_GA), WSP(bf16, WS_GB), WSP(float, WS_TMP), WSP(bf16, WS_MB)};
        pg8::gemm_phase<EpiMerge, MergeOrder, true, true>(ring, g, S, E);
    } SEAM(6);
    if (IN(7)) {
        pg8::Gemm g{WSP(bf16, WS_MB), WSP(bf16, WS_WO), M, DM, DM, DM}; StaticOrder S; S.init(M, DM, F.G, (int)blockIdx.x);
        EpiRes E{F.xp, F.xs, WSP(float, WS_X1), WSP(bf16, WS_X1B), (float*)(F.ctl + CW_SS1)};
        pg8::gemm_phase<EpiRes, StaticOrder, true, true>(ring, g, S, E);
    } SEAM(7);
    if (IN(8)) {
        pg8::Gemm g{WSP(bf16, WS_X1B), WSP(bf16, WS_WUP), M, FF, DM, DM}; StaticOrder S; S.init(M, FF, F.G, (int)blockIdx.x);
        EpiUp E{(const float*)(F.ctl + CW_SS1), WSP(bf16, WS_H)};
        pg8::gemm_phase<EpiUp, StaticOrder, true, true>(ring, g, S, E);
    } SEAM(8);
    if (IN(9)) {
        pg8::Gemm g{WSP(bf16, WS_H), WSP(bf16, WS_WDN), M, DM, FF, FF}; StaticOrder S; S.init(M, DM, F.G, (int)blockIdx.x);
        const float* x1 = WSP(float, WS_X1);
        EpiRes E{x1, x1 + (size_t)MP * DM, F.out + O_Y, nullptr, (float*)(F.ctl + CW_SS2)};
        pg8::gemm_phase<EpiRes, StaticOrder, true, true>(ring, g, S, E);
    } SEAM(9);
    if (IN(10)) { p10_final(F); }
#undef IN
#undef SEAM
}

extern "C" void kernel_launch(void* const* d_in, const int* in_sizes, int n_in, void* d_out, int out_size, void* d_ws, size_t ws_size, hipStream_t stream) {
    static int grid = 0;
    if (grid == 0) {
        if (n_in != 21 || out_size != (int)O_END || ws_size < WS_END) { fprintf(stderr, "kernel_launch: unexpected shapes (n_in %d, out %d, ws %zu); nothing launched\n", n_in, out_size, ws_size); grid = -1; return; }
        int dev = 0, cus = 0, per_cu = 0;
        if (hipGetDevice(&dev) != hipSuccess || hipDeviceGetAttribute(&cus, hipDeviceAttributeMultiprocessorCount, dev) != hipSuccess) { grid = -1; return; }
        if (hipFuncSetAttribute((const void*)mk_fwd, hipFuncAttributeMaxDynamicSharedMemorySize, LDS_BYTES) != hipSuccess) { fprintf(stderr, "kernel_launch: hipFuncSetAttribute failed\n"); grid = -1; return; }
        if (hipOccupancyMaxActiveBlocksPerMultiprocessor(&per_cu, (const void*)mk_fwd, NTHR, LDS_BYTES) != hipSuccess || per_cu < 1) { fprintf(stderr, "kernel_launch: occupancy query says %d\n", per_cu); }
        (void)hipGetLastError();
        grid = cus;
    }
    if (grid < 0) return;
    if (hipMemsetAsync((char*)d_ws + WS_CTL, 0, CTL_ZERO_BYTES, stream) != hipSuccess) return;
    Args a{};
    for (int i = 0; i < 21; ++i) a.in[i] = d_in[i];
    a.out = (float*)d_out; a.ws = (unsigned char*)d_ws;
    if (MK_N_LAUNCHES == 1) { a.ph_lo = 0; a.ph_hi = N_PHASES; hipLaunchKernelGGL(mk_fwd, dim3(grid), dim3(NTHR), LDS_BYTES, stream, a); }
    else for (int p = 0; p < N_PHASES; ++p) { a.ph_lo = p; a.ph_hi = p + 1; hipLaunchKernelGGL(mk_fwd, dim3(grid), dim3(NTHR), LDS_BYTES, stream, a); }
}
```

```cpp
#include <hip/hip_runtime.h>
#include <cstdio>
#include <cstdint>

#ifndef PROBE_REPEAT_MASK
#define PROBE_REPEAT_MASK 0
#endif
#ifndef PROBE_WAIT_PHASE
#define PROBE_WAIT_PHASE -1
#endif
#ifndef MK_N_LAUNCHES
#define MK_N_LAUNCHES 1
#endif

namespace pg8 {
#define PG8_LAS __attribute__((address_space(3)))
typedef unsigned short bf16_t;
typedef short bf16x8 __attribute__((ext_vector_type(8)));
typedef float f32x4 __attribute__((ext_vector_type(4)));
typedef unsigned u32x4 __attribute__((ext_vector_type(4)));
constexpr int BM = 256, BK = 64, HALF = 128, HTB = HALF * BK * 2  , STAGE_BYTES = 8 * HTB, NXCD = 8, WGM = 8;

__host__ __device__ __forceinline__ int lds_byte(int r, int c) { const int st = (r >> 4) * 2 + (c >> 5), rr = r & 15, cc = c & 31, ob = rr * 64 + cc * 2; return st * 1024 + (ob ^ (((ob >> 9) & 1) << 5)); }
__host__ __device__ __forceinline__ void stage_rc(int b, int& R, int& C) { const int st = b / 1024, sb = b % 1024, swz = sb ^ (((sb >> 9) & 1) << 5); R = (st >> 1) * 16 + swz / 64; C = (st & 1) * 32 + (swz % 64) / 2; }
__host__ __device__ __forceinline__ int perm32(int rho) { const int n = rho >> 4, i = rho & 15; return 8 * (i >> 2) + 4 * n + (i & 3); }

struct Unit { int pm, pn, ko, nk; };
struct Gemm { const bf16_t* A; const bf16_t* Bt; int M, N, K, ld; };
typedef float f32x2_t __attribute__((ext_vector_type(2))); typedef __bf16 bf16x2_t __attribute__((ext_vector_type(2)));
__device__ __forceinline__ unsigned cvt_pk_bf16(float lo, float hi) { f32x2_t v = {lo, hi}; bf16x2_t b = __builtin_convertvector(v, bf16x2_t); return __builtin_bit_cast(unsigned, b); }


template <class Epi, class Sched, bool ALIGN_EPI = false, bool SP2 = false>
__device__ __forceinline__ void gemm_phase(PG8_LAS unsigned char* lds, const Gemm g, const Sched& S, const Epi& E) {
    const int tid = threadIdx.x, wid = __builtin_amdgcn_readfirstlane(tid >> 6), lane = tid & 63, wr = wid >> 2, wc = wid & 3, fr = lane & 15, fq = lane >> 4;
    const int K = g.ld, nt0 = g.K / BK;
    unsigned voffA[2], voffB[2];
#pragma unroll
    for (int i = 0; i < 2; ++i) { int R, C; stage_rc(tid * 16 + i * 8192, R, C); const int Rb = Epi::PERM ? ((R & ~31) + perm32(R & 31)) : R;
        voffA[i] = (unsigned)(R * K + C) * 2u; voffB[i] = (unsigned)(Rb * K + C) * 2u; }
    const size_t kstep = (size_t)(BK * 2);
    const size_t hstep = (size_t)HALF * K * 2;
    const size_t tstep = 2 * hstep;
    const unsigned ldsw = (unsigned)wid * 1024u;
    const int aoff = lds_byte(wr * 64 + fr, fq * 8), boff = lds_byte(wc * 32 + fr, fq * 8);
#define PG8_SA(b, h) (((b) * 2 + (h)) * HTB)
#define PG8_SB(b, h) ((4 + (b) * 2 + (h)) * HTB)
#define PG8_STAGE(bufoff, gbase, voff) do { _Pragma("unroll") for (int _i = 0; _i < 2; ++_i) \
        __builtin_amdgcn_global_load_lds((const unsigned*)((const char*)(gbase) + (voff)[_i]), (PG8_LAS unsigned*)(lds + (bufoff) + ldsw + _i * 8192), 16, 0, 0); } while (0)
#define PG8_LDA(dst, b, h) do { _Pragma("unroll") for (int m = 0; m < 4; ++m) _Pragma("unroll") for (int k = 0; k < 2; ++k) dst[m][k] = *(const PG8_LAS bf16x8*)(lds + PG8_SA(b, h) + aoff + m * 2048 + k * 1024); } while (0)
#define PG8_LDB(dst, b, h) do { _Pragma("unroll") for (int n = 0; n < 2; ++n) _Pragma("unroll") for (int k = 0; k < 2; ++k) dst[n][k] = *(const PG8_LAS bf16x8*)(lds + PG8_SB(b, h) + boff + n * 2048 + k * 1024); } while (0)
#define PG8_MMA(ai, bj, At, Bt) do { __builtin_amdgcn_s_setprio(1); _Pragma("unroll") for (int m = 0; m < 4; ++m) _Pragma("unroll") for (int n = 0; n < 2; ++n) _Pragma("unroll") for (int k = 0; k < 2; ++k) \
        acc[ai][bj][m][n] = __builtin_amdgcn_mfma_f32_16x16x32_bf16(Bt[n][k], At[m][k], acc[ai][bj][m][n], 0, 0, 0); __builtin_amdgcn_s_setprio(0); } while (0)
#define PG8_WAIT_V(n) asm volatile("s_waitcnt vmcnt(" #n ")" ::: "memory")
#define PG8_WAIT_L(n) asm volatile("s_waitcnt lgkmcnt(" #n ")" ::: "memory")
#define PG8_BAR __builtin_amdgcn_s_barrier()
#define PG8_SCHED __builtin_amdgcn_sched_barrier(0)
    Unit cur, nxt; int ui = 0;
    if (!S.next(0, cur)) return;
    f32x4 acc[2][2][4][2];
#pragma unroll
    for (int a = 0; a < 2; ++a)
#pragma unroll
        for (int b = 0; b < 2; ++b)
#pragma unroll
            for (int m = 0; m < 4; ++m)
#pragma unroll
                for (int n = 0; n < 2; ++n) acc[a][b][m][n] = (f32x4){0.f, 0.f, 0.f, 0.f};
    bf16x8 At[4][2], B0[2][2], B1[2][2];
    const char* cA = (const char*)g.A + (size_t)cur.pm * tstep + (size_t)cur.ko * 2; const char* cB = (const char*)g.Bt + (size_t)cur.pn * tstep + (size_t)cur.ko * 2;
    S.a_ready(cur);
    if constexpr (SP2) {
        PG8_STAGE(PG8_SB(0, 0), cB, voffB); PG8_STAGE(PG8_SB(0, 1), cB + hstep, voffB); PG8_STAGE(PG8_SA(0, 0), cA, voffA); PG8_STAGE(PG8_SA(0, 1), cA + hstep, voffA);
        if (wr == 1) PG8_BAR;
        PG8_WAIT_V(2); PG8_BAR;
        PG8_STAGE(PG8_SB(1, 0), cB + kstep, voffB); PG8_STAGE(PG8_SA(1, 0), cA + kstep, voffA); PG8_STAGE(PG8_SB(1, 1), cB + hstep + kstep, voffB);
        PG8_WAIT_V(6); PG8_BAR;
    } else {
        PG8_STAGE(PG8_SB(0, 0), cB, voffB); PG8_STAGE(PG8_SA(0, 0), cA, voffA); PG8_STAGE(PG8_SB(0, 1), cB + hstep, voffB); PG8_STAGE(PG8_SA(0, 1), cA + hstep, voffA);
        if (wr == 1) PG8_BAR;
        PG8_WAIT_V(4); PG8_BAR;
        PG8_STAGE(PG8_SB(1, 0), cB + kstep, voffB); PG8_STAGE(PG8_SA(1, 0), cA + kstep, voffA); PG8_STAGE(PG8_SB(1, 1), cB + hstep + kstep, voffB);
        PG8_WAIT_V(6); PG8_BAR;
    }
    for (;;) {
        const bool has_next = S.next(ui + 1, nxt);
        const char* nA = has_next ? (const char*)g.A + (size_t)nxt.pm * tstep + (size_t)nxt.ko * 2 : cA; const char* nB = has_next ? (const char*)g.Bt + (size_t)nxt.pn * tstep + (size_t)nxt.ko * 2 : cB;
        const int nt = cur.nk ? cur.nk : nt0;
        for (int t = 0; t < nt; t += 2) {
            const bool last = (t == nt - 2);
            const char* a1 = cA + (size_t)(t + 1) * kstep;
            const char* a2 = last ? nA : cA + (size_t)(t + 2) * kstep; const char* b2 = last ? nB : cB + (size_t)(t + 2) * kstep;
            const char* a3 = a2 + kstep; const char* b3 = b2 + kstep;
            if (last && has_next) S.a_ready(nxt);
            if constexpr (SP2) {
            PG8_LDB(B0, 0, 0); PG8_LDB(B1, 0, 1); PG8_SCHED; PG8_LDA(At, 0, 0); PG8_STAGE(PG8_SA(1, 1), a1 + hstep, voffA);
            PG8_WAIT_V(8); PG8_WAIT_L(0); PG8_BAR; PG8_MMA(0, 0, At, B0); PG8_MMA(0, 1, At, B1); PG8_BAR; PG8_SCHED;
            PG8_LDA(At, 0, 1); PG8_STAGE(PG8_SB(0, 0), b2, voffB); PG8_STAGE(PG8_SB(0, 1), b2 + hstep, voffB); PG8_STAGE(PG8_SA(0, 0), a2, voffA);
            PG8_WAIT_V(8); PG8_WAIT_L(0); PG8_BAR; PG8_MMA(1, 0, At, B0); PG8_MMA(1, 1, At, B1); PG8_BAR; PG8_SCHED;
            PG8_LDB(B0, 1, 0); PG8_LDB(B1, 1, 1); PG8_SCHED; PG8_LDA(At, 1, 0); PG8_STAGE(PG8_SA(0, 1), a2 + hstep, voffA);
            PG8_WAIT_V(8); PG8_WAIT_L(0); PG8_BAR; PG8_MMA(0, 0, At, B0); PG8_MMA(0, 1, At, B1); PG8_BAR; PG8_SCHED;
            PG8_LDA(At, 1, 1); PG8_STAGE(PG8_SB(1, 0), b3, voffB); PG8_STAGE(PG8_SB(1, 1), b3 + hstep, voffB); PG8_STAGE(PG8_SA(1, 0), a3, voffA);
            PG8_WAIT_V(8); PG8_WAIT_L(0); PG8_BAR; PG8_MMA(1, 0, At, B0); PG8_MMA(1, 1, At, B1); PG8_BAR; PG8_SCHED;
            } else {
            PG8_LDB(B0, 0, 0); PG8_SCHED; PG8_LDA(At, 0, 0); PG8_STAGE(PG8_SA(1, 1), a1 + hstep, voffA);
            PG8_WAIT_L(8); PG8_BAR; PG8_WAIT_L(0); PG8_MMA(0, 0, At, B0); PG8_BAR; PG8_SCHED;
            PG8_LDB(B1, 0, 1); PG8_STAGE(PG8_SB(0, 0), b2, voffB);
            PG8_BAR; PG8_WAIT_L(0); PG8_MMA(0, 1, At, B1); PG8_BAR;
            PG8_LDA(At, 0, 1); PG8_STAGE(PG8_SA(0, 0), a2, voffA);
            PG8_BAR; PG8_WAIT_L(0); PG8_MMA(1, 0, At, B0); PG8_BAR; PG8_SCHED;
            PG8_STAGE(PG8_SB(0, 1), b2 + hstep, voffB);
            PG8_WAIT_V(6); PG8_BAR; PG8_MMA(1, 1, At, B1); PG8_BAR;
            PG8_LDB(B0, 1, 0); PG8_SCHED; PG8_LDA(At, 1, 0); PG8_STAGE(PG8_SA(0, 1), a2 + hstep, voffA);
            PG8_WAIT_L(8); PG8_BAR; PG8_WAIT_L(0); PG8_MMA(0, 0, At, B0); PG8_BAR; PG8_SCHED;
            PG8_LDB(B1, 1, 1); PG8_STAGE(PG8_SB(1, 0), b3, voffB);
            PG8_BAR; PG8_WAIT_L(0); PG8_MMA(0, 1, At, B1); PG8_BAR;
            PG8_LDA(At, 1, 1); PG8_STAGE(PG8_SA(1, 0), a3, voffA);
            PG8_BAR; PG8_WAIT_L(0); PG8_MMA(1, 0, At, B0); PG8_BAR; PG8_SCHED;
            PG8_STAGE(PG8_SB(1, 1), b3 + hstep, voffB);
            PG8_WAIT_V(6); PG8_BAR; PG8_MMA(1, 1, At, B1); PG8_BAR;
            }
        }
        if constexpr (ALIGN_EPI) { if (wr == 0) PG8_BAR; }
        if constexpr (!Epi::AFTER_DRAIN) { E(acc, cur, wr, wc, fr, fq); S.done(cur); }
        if (!has_next) break;
        if (!(Epi::MIDK > 0 && cur.ko == 0)) {
#pragma unroll
        for (int a = 0; a < 2; ++a)
#pragma unroll
            for (int b = 0; b < 2; ++b)
#pragma unroll
                for (int m = 0; m < 4; ++m)
#pragma unroll
                    for (int n = 0; n < 2; ++n) acc[a][b][m][n] = (f32x4){0.f, 0.f, 0.f, 0.f};
        }
        cur = nxt; cA = nA; cB = nB; ++ui;
        if constexpr (ALIGN_EPI) { if (wr == 1) PG8_BAR; }
    }
    PG8_WAIT_V(0);
    if constexpr (!ALIGN_EPI) { if (wr == 0) PG8_BAR; }
    PG8_BAR;
    if constexpr (Epi::AFTER_DRAIN) { E.fused(acc, cur, wr, wc, fr, fq, lds, wid, lane); S.done(cur); }
#undef PG8_SA
#undef PG8_SB
#undef PG8_STAGE
#undef PG8_LDA
#undef PG8_LDB
#undef PG8_MMA
#undef PG8_WAIT_V
#undef PG8_WAIT_L
#undef PG8_BAR
#undef PG8_SCHED
}
}


#define GAS __attribute__((address_space(1)))
#define LAS __attribute__((address_space(3)))
typedef unsigned short bf16;
typedef unsigned v4u __attribute__((ext_vector_type(4)));
typedef float f32x4 __attribute__((ext_vector_type(4)));
typedef short bf16x8 __attribute__((ext_vector_type(8)));
typedef GAS unsigned gu32;
typedef GAS unsigned long long gu64;
#define RLX_AGENT __ATOMIC_RELAXED, __HIP_MEMORY_SCOPE_AGENT
#define LDS_WAIT() asm volatile("s_waitcnt lgkmcnt(0)" ::: "memory")
#define VM_WAIT() asm volatile("s_waitcnt vmcnt(0)" ::: "memory")
__device__ __forceinline__ unsigned long long rt() { return __builtin_amdgcn_s_memrealtime(); }
__device__ __forceinline__ unsigned f2bf(float f) { unsigned u = __builtin_bit_cast(unsigned, f); return (u + 0x7fffu + ((u >> 16) & 1u)) >> 16; }
__device__ __forceinline__ unsigned pk2(float lo, float hi) { return f2bf(lo) | (f2bf(hi) << 16); }

#define XB_TMO      128
#define XB_XCNT(j)  (256  + 64 * (j))
#define XB_XSUB(j)  (1280 + 64 * (j))
#define XB_XGEN(j)  (2304 + 64 * (j))
#define XB_TOP      3328
#define XB_TOPGEN   3392
#define XCD_BAR_WORDS 3456
#define XB_SPIN_CAP (1u << 18)

__device__ __forceinline__ unsigned xb_ld(unsigned* p)              { return __hip_atomic_load(p, __ATOMIC_RELAXED, __HIP_MEMORY_SCOPE_AGENT); }
__device__ __forceinline__ unsigned xb_add(unsigned* p, unsigned v) { return __hip_atomic_fetch_add(p, v, __ATOMIC_RELAXED, __HIP_MEMORY_SCOPE_AGENT); }
__device__ __forceinline__ unsigned xb_xcc_id() { return (unsigned)__builtin_amdgcn_s_getreg((3 << 11) | 20) & 0xFu; }
#define XB_SPIN(cond, bar) do { unsigned _sp = 0; while (cond) { __builtin_amdgcn_s_sleep(1); \
    if ((++_sp & 255u) == 0u) { if (xb_ld(&(bar)[XB_TMO])) break; if (_sp > XB_SPIN_CAP) { atomicAdd(&(bar)[XB_TMO], 1u); break; } } } } while (0)

struct XcdBarrier {
    unsigned* bar; unsigned x;
    volatile LAS unsigned* st;
};

__device__ __forceinline__ XcdBarrier xcd_barrier_post(unsigned* bar, volatile LAS unsigned* st) {
    XcdBarrier b; b.bar = bar; b.x = xb_xcc_id(); b.st = st;
    if (threadIdx.x == 0) (void)xb_add(&bar[XB_XCNT(b.x)], 1u);
    return b;
}
__device__ __forceinline__ void xcd_barrier_complete(unsigned* bar, unsigned x, unsigned& nloc, unsigned& nx) {
    const unsigned G = gridDim.x * gridDim.y * gridDim.z;
    unsigned sum, cnt, mine, sp = 0u;
    for (;;) {
        sum = 0u; cnt = 0u; mine = 0u;
#pragma unroll
        for (unsigned j = 0; j < 16; ++j) { const unsigned c = xb_ld(&bar[XB_XCNT(j)]); sum += c; cnt += (c > 0u) ? 1u : 0u; mine = (j == x) ? c : mine; }
        if (sum == G) break;
        __builtin_amdgcn_s_sleep(1);
        if ((++sp & 255u) == 0u) { if (xb_ld(&bar[XB_TMO])) break; if (sp > XB_SPIN_CAP) { atomicAdd(&bar[XB_TMO], 1u); break; } }
    }
    nloc = mine > 0u ? mine : 1u; nx = cnt > 0u ? cnt : 1u;
}

__device__ __forceinline__ void xcd_barrier(const XcdBarrier& b) {
    asm volatile("s_waitcnt vmcnt(0)" ::: "memory");
    __syncthreads();
    if (threadIdx.x == 0) {
        unsigned* bar = b.bar;
        __builtin_amdgcn_s_waitcnt(0);
        unsigned nloc = b.st[0], nx = b.st[1];
        if (nloc == 0u) { xcd_barrier_complete(bar, b.x, nloc, nx); b.st[0] = nloc; b.st[1] = nx; }
        const unsigned old = xb_add(&bar[XB_XSUB(b.x)], 1u);
        const unsigned gen = old / nloc;
        if (old + 1u == (gen + 1u) * nloc) {
            __builtin_amdgcn_fence(__ATOMIC_RELEASE, "agent");
            asm volatile("s_waitcnt vmcnt(0)" ::: "memory");
            const unsigned og = xb_add(&bar[XB_TOP], 1u);
            const unsigned tg = og / nx;
            if (og + 1u == (tg + 1u) * nx) xb_add(&bar[XB_TOPGEN], 1u);
            else XB_SPIN(xb_ld(&bar[XB_TOPGEN]) == tg, bar);
            __builtin_amdgcn_fence(__ATOMIC_ACQUIRE, "agent");
            xb_add(&bar[XB_XGEN(b.x)], 1u);
            asm volatile("s_waitcnt vmcnt(0)" ::: "memory");
        } else {
            XB_SPIN(xb_ld(&bar[XB_XGEN(b.x)]) == gen, bar);
            __builtin_amdgcn_fence(__ATOMIC_ACQUIRE, "agent");
            asm volatile("s_waitcnt vmcnt(0)" ::: "memory");
        }
    }
    __syncthreads();
}


constexpr int DM = 1024, TP = 8192, NBP = 2, MP = NBP * TP, NBS = 128, TS = 4, MS = NBS * TS, M = MP + MS;
constexpr int SBH = 8, SBD = 64, SBDIM = 512, GH = 4, GD = 128, GDIM = 512, CONVD = 1536, FF = 4096;
constexpr int PAST = 2048, PAGE = 128, NPAGES = 16;
constexpr int INW = 5640, NIN = 5632;
constexpr float NORM_EPS = 1e-6f, L2_EPS = 1e-6f, LOG2E = 1.4426950408889634f, QSCALE = 0.125f * 1.4426950408889634f;
constexpr int NWAVES = 8, NTHR = 512;

constexpr size_t O_Y = 0, O_KP = (size_t)M * DM, O_VP = O_KP + (size_t)MP * 512, O_KS = O_VP + (size_t)MP * 512, O_VS = O_KS + (size_t)MS * 512,
    O_CP = O_VS + (size_t)MS * 512, O_CS = O_CP + (size_t)NBP * 3 * CONVD, O_SP = O_CS + (size_t)NBS * 3 * CONVD, O_SS = O_SP + (size_t)NBP * GH * GD * GD,
    O_END = O_SS + (size_t)NBS * GH * GD * GD;
static_assert(O_END == 43721728, "output size");

constexpr size_t MiB = 1u << 20;
constexpr size_t WS_CTL = 0, CTL_ZERO_BYTES = 1 * MiB;
constexpr size_t WS_WIN = 2 * MiB, WS_WCAT = 14 * MiB, WS_WO = 16 * MiB, WS_WUP = 18 * MiB, WS_WDN = 26 * MiB;
constexpr size_t WS_AB = 34 * MiB, WS_GBETA = 35 * MiB, WS_XN = 36 * MiB, WS_QA = 69 * MiB, WS_KA = 86 * MiB, WS_VA = 103 * MiB, WS_U = 120 * MiB;
constexpr size_t WS_ZB = 219 * MiB, WS_GA = 236 * MiB, WS_GB = 269 * MiB, WS_OCAT = 302 * MiB, WS_TMP = 335 * MiB, WS_MB = 401 * MiB, WS_X1 = 434 * MiB, WS_X1B = 500 * MiB;
constexpr size_t WS_H = 533 * MiB, WS_QKVN = 665 * MiB, WS_ORAW = 764 * MiB, WS_GREC = 800 * MiB, WS_GUT = 856 * MiB, WS_GEG = 888 * MiB, WS_SPO = 889 * MiB, WS_SPR = 894 * MiB, WS_SLAB = 895 * MiB, WS_END = 927 * MiB;
constexpr int CW_TMO = 0, CW_CODE = 1, CW_BAR = 4096, CW_SS1 = 65536, CW_SS2 = 98304, CW_SSD = 131072, CW_PC = 150016;
static_assert((CW_SSD + M) * 4 <= (int)CTL_ZERO_BYTES, "control words inside the memset region");

constexpr int RING_OFF = 0, RING_BYTES = 131072, LDS_BYTES = 147456, LDSCTL_OFF = LDS_BYTES - 1024, MISC_OFF = LDSCTL_OFF + 320;

__device__ __forceinline__ float bf2f(bf16 b) { return __uint_as_float((unsigned)b << 16); }
__device__ __forceinline__ float wave_sum(float v) {
#define WS_DPP(x, ctrl, rmask) __builtin_bit_cast(float, __builtin_amdgcn_update_dpp(0, __builtin_bit_cast(int, (x)), (ctrl), (rmask), 0xF, false))
    v += WS_DPP(v, 0xB1, 0xF);
    v += WS_DPP(v, 0x4E, 0xF);
    v += WS_DPP(v, 0x141, 0xF);
    v += WS_DPP(v, 0x140, 0xF);
    v += WS_DPP(v, 0x142, 0xA);
    v += WS_DPP(v, 0x143, 0xC);
#undef WS_DPP
    return __builtin_bit_cast(float, __builtin_amdgcn_readlane(__builtin_bit_cast(int, v), 63));
}
__device__ __forceinline__ float sigmoidf_(float x) { return __builtin_amdgcn_rcpf(1.f + __expf(-x)); }

struct Frame {
    LAS unsigned char* lds;
    volatile LAS unsigned* MISC;
    gu32* ctl;
    int tid, lane, wave, vcu, G;
    const float *xp, *xs, *cache_k, *cache_v, *state_conv, *state_ssm, *norm_mix_w, *w_in, *sb_bias, *conv_w, *a_log, *dt_bias, *gdn_norm_w, *w_pa, *w_pb, *w_o, *norm_mlp_w, *w_up, *w_down, *norm_final_w;
    const int* page_table;
    float* out; unsigned char* ws;
};
#define WSP(T, off) ((T*)(F.ws + (off)))

struct StaticOrder {
    int nM, nN, nwg, G, c;
    __device__ void init(int M_, int N_, int G_, int c_) { nM = M_ / pg8::BM; nN = N_ / pg8::BM; nwg = nM * nN; G = G_; c = c_; }
    __device__ bool next(int i, pg8::Unit& u) const {
        const long L = (long)i * G + c; if (L >= nwg) return false;
        int wgid = (int)L; { const int q = nwg / pg8::NXCD, r = nwg % pg8::NXCD, xcd = wgid % pg8::NXCD, off = wgid / pg8::NXCD; wgid = (xcd < r ? xcd * (q + 1) : r * (q + 1) + (xcd - r) * q) + off; }
        const int nig = pg8::WGM * nN, gid = wgid / nig, fm = gid * pg8::WGM, gsz = (nM - fm) < pg8::WGM ? (nM - fm) : pg8::WGM;
        u.pm = fm + ((wgid % nig) % gsz); u.pn = (wgid % nig) / gsz; u.ko = 0; u.nk = 0; return true;
    }
    __device__ __forceinline__ void a_ready(const pg8::Unit&) const {}
    __device__ __forceinline__ void done(const pg8::Unit&) const {}
};
struct MergeOrder {
    int G, c, ntile;
    __device__ bool next(int i, pg8::Unit& u) const { const int t = (i >> 1) * G + c; if (t >= ntile) return false; u.pm = t >> 2; u.pn = t & 3; u.ko = (i & 1) * 512; u.nk = 0; return true; }
    __device__ __forceinline__ void a_ready(const pg8::Unit&) const {}
    __device__ __forceinline__ void done(const pg8::Unit&) const {}
};

struct DownOrder {
    StaticOrder P; int c;
    __device__ bool next(int i, pg8::Unit& u) const {
        const int np = c < P.nwg ? (P.nwg - 1 - c) / P.G + 1 : 0;
        if (i < np) return P.next(i, u);
        const int su = (i - np) * P.G + c; if (su >= 128) return false;
        u.pm = MP / 256 + (su >> 6); u.pn = (su >> 4) & 3; u.ko = 256 * (su & 15); u.nk = 4; return true; }
    __device__ __forceinline__ void a_ready(const pg8::Unit&) const {}
    __device__ __forceinline__ void done(const pg8::Unit&) const {}
};
typedef pg8::f32x4 a4;
#define EPI_LOOP_BEGIN const int row0 = u.pm * 256 + wr * 64 + fr; const int cw = wc * 32 + 8 * fq; \
    _Pragma("unroll") for (int ai = 0; ai < 2; ++ai) _Pragma("unroll") for (int m = 0; m < 4; ++m) { const int row = row0 + ai * 128 + m * 16; \
    _Pragma("unroll") for (int bj = 0; bj < 2; ++bj) { const int col = u.pn * 256 + bj * 128 + cw; a4 v0 = acc[ai][bj][m][0], v1 = acc[ai][bj][m][1];
#define EPI_LOOP_END } }
__device__ __forceinline__ v4u pack8(a4 v0, a4 v1) { v4u w; w.x = pg8::cvt_pk_bf16(v0[0], v0[1]); w.y = pg8::cvt_pk_bf16(v0[2], v0[3]); w.z = pg8::cvt_pk_bf16(v1[0], v1[1]); w.w = pg8::cvt_pk_bf16(v1[2], v1[3]); return w; }
__device__ __forceinline__ void unpack8(v4u w, a4& v0, a4& v1) {
    v0[0] = __uint_as_float(w.x << 16); v0[1] = __uint_as_float(w.x & 0xffff0000u); v0[2] = __uint_as_float(w.y << 16); v0[3] = __uint_as_float(w.y & 0xffff0000u);
    v1[0] = __uint_as_float(w.z << 16); v1[1] = __uint_as_float(w.z & 0xffff0000u); v1[2] = __uint_as_float(w.w << 16); v1[3] = __uint_as_float(w.w & 0xffff0000u); }

struct EpiIn {
    static constexpr bool PERM = true, AFTER_DRAIN = false; static constexpr int MIDK = 0;
    bf16 *Qa, *Ka, *Va, *Zb, *GA, *GB; float* U; float* out;
    __device__ __forceinline__ void operator()(const a4 (&acc)[2][2][4][2], const pg8::Unit& u, int wr, int wc, int fr, int fq) const {
        const int pn = u.pn;
        EPI_LOOP_BEGIN
            if (pn < 2) { *(v4u*)(Qa + (size_t)row * 512 + col) = pack8(v0 * QSCALE, v1 * QSCALE); }
            else if (pn < 6) { const bool isk = pn < 4; const int cc = col - (isk ? 512 : 1024);
                float* o = out + (row < MP ? (isk ? O_KP : O_VP) + (size_t)row * 512 : (isk ? O_KS : O_VS) + (size_t)(row - MP) * 512) + cc;
                *(a4*)o = v0; *(a4*)(o + 4) = v1; *(v4u*)((isk ? Ka : Va) + (size_t)row * 512 + cc) = pack8(v0, v1); }
            else if (pn < 12) { float* o = U + (size_t)row * CONVD + (col - 1536); *(a4*)o = v0; *(a4*)(o + 4) = v1; }
            else if (pn < 14) { *(v4u*)(Zb + (size_t)row * 512 + (col - 3072)) = pack8(v0, v1); }
            else { const bool isa = pn < 18; const int cc = col - (isa ? 3584 : 4608);
#pragma unroll
                for (int e = 0; e < 4; ++e) { v0[e] = sigmoidf_(v0[e]); v1[e] = sigmoidf_(v1[e]); }
                *(v4u*)((isa ? GA : GB) + (size_t)row * DM + cc) = pack8(v0, v1); }
        EPI_LOOP_END
    }
};
struct EpiMerge {
    static constexpr bool PERM = true, AFTER_DRAIN = false; static constexpr int MIDK = 8;
    const bf16 *GA, *GB; bf16* Mb;
    __device__ __forceinline__ void operator()(a4 (&acc)[2][2][4][2], const pg8::Unit& u, int wr, int wc, int fr, int fq) const {
        const int row0 = u.pm * 256 + wr * 64 + fr, cw = u.pn * 256 + wc * 32 + 8 * fq;
        if (u.ko == 0) {
#pragma unroll
            for (int ai = 0; ai < 2; ++ai) {
                v4u gb[4][2], ga[4][2];
#pragma unroll
                for (int m = 0; m < 4; ++m)
#pragma unroll
                    for (int bj = 0; bj < 2; ++bj) { const size_t idx = (size_t)(row0 + ai * 128 + m * 16) * DM + cw + bj * 128; gb[m][bj] = *(const GAS v4u*)(GB + idx); ga[m][bj] = *(const GAS v4u*)(GA + idx); }
#pragma unroll
                for (int m = 0; m < 4; ++m)
#pragma unroll
                    for (int bj = 0; bj < 2; ++bj) { a4 b0, b1, a0, a1; unpack8(gb[m][bj], b0, b1); unpack8(ga[m][bj], a0, a1);
#pragma unroll
                        for (int e = 0; e < 4; ++e) { acc[ai][bj][m][0][e] *= a0[e] * __builtin_amdgcn_rcpf(fmaxf(b0[e], 1e-30f)); acc[ai][bj][m][1][e] *= a1[e] * __builtin_amdgcn_rcpf(fmaxf(b1[e], 1e-30f)); } }
            }
        } else {
#pragma unroll
            for (int ai = 0; ai < 2; ++ai) {
                v4u gb[4][2];
#pragma unroll
                for (int m = 0; m < 4; ++m)
#pragma unroll
                    for (int bj = 0; bj < 2; ++bj) gb[m][bj] = *(const GAS v4u*)(GB + (size_t)(row0 + ai * 128 + m * 16) * DM + cw + bj * 128);
#pragma unroll
                for (int m = 0; m < 4; ++m)
#pragma unroll
                    for (int bj = 0; bj < 2; ++bj) { a4 b0, b1; unpack8(gb[m][bj], b0, b1);
                        *(v4u*)(Mb + (size_t)(row0 + ai * 128 + m * 16) * DM + cw + bj * 128) = pack8(acc[ai][bj][m][0] * b0, acc[ai][bj][m][1] * b1); }
            }
        }
    }
};
struct EpiRes {
    static constexpr bool PERM = true, AFTER_DRAIN = false; static constexpr int MIDK = 0;
    const float *baseP, *baseS; float* Rf; bf16* Rb; float* SS;
    __device__ __forceinline__ void operator()(const a4 (&acc)[2][2][4][2], const pg8::Unit& u, int wr, int wc, int fr, int fq) const {
        const int row0 = u.pm * 256 + wr * 64 + fr, cw = u.pn * 256 + wc * 32 + 8 * fq;
#pragma unroll
        for (int ai = 0; ai < 2; ++ai) {
            a4 b[4][2][2];
#pragma unroll
            for (int m = 0; m < 4; ++m)
#pragma unroll
                for (int bj = 0; bj < 2; ++bj) { const int row = row0 + ai * 128 + m * 16;
                    const GAS float* p = (const GAS float*)(row < MP ? baseP + (size_t)row * DM : baseS + (size_t)(row - MP) * DM) + cw + bj * 128; b[m][bj][0] = *(const GAS a4*)p; b[m][bj][1] = *(const GAS a4*)(p + 4); }
#pragma unroll
            for (int m = 0; m < 4; ++m) { const int row = row0 + ai * 128 + m * 16; float ss = 0.f;
#pragma unroll
                for (int bj = 0; bj < 2; ++bj) { const a4 r0 = b[m][bj][0] + acc[ai][bj][m][0], r1 = b[m][bj][1] + acc[ai][bj][m][1]; const size_t idx = (size_t)row * DM + cw + bj * 128;
                    *(a4*)(Rf + idx) = r0; *(a4*)(Rf + idx + 4) = r1; if (Rb) *(v4u*)(Rb + idx) = pack8(r0, r1);
                    ss += (r0[0] * r0[0] + r0[1] * r0[1]) + (r0[2] * r0[2] + r0[3] * r0[3]) + (r1[0] * r1[0] + r1[1] * r1[1]) + (r1[2] * r1[2] + r1[3] * r1[3]); }
                ss += __shfl_xor(ss, 16); ss += __shfl_xor(ss, 32);
                if (fq == 0) __hip_atomic_fetch_add(SS + row, ss, __ATOMIC_RELAXED, __HIP_MEMORY_SCOPE_AGENT); }
        }
    }
};
struct EpiDown {
    static constexpr bool PERM = true, AFTER_DRAIN = false; static constexpr int MIDK = 0;
    const float* X1; float* Y;
    __device__ __forceinline__ void operator()(const a4 (&acc)[2][2][4][2], const pg8::Unit& u, int wr, int wc, int fr, int fq) const {
        const int row0 = u.pm * 256 + wr * 64 + fr, cw = u.pn * 256 + wc * 32 + 8 * fq;
#pragma unroll
        for (int ai = 0; ai < 2; ++ai) {
            a4 b[4][2][2];
#pragma unroll
            for (int m = 0; m < 4; ++m)
#pragma unroll
                for (int bj = 0; bj < 2; ++bj) { const GAS float* p = (const GAS float*)X1 + (size_t)(row0 + ai * 128 + m * 16) * DM + cw + bj * 128; b[m][bj][0] = *(const GAS a4*)p; b[m][bj][1] = *(const GAS a4*)(p + 4); }
#pragma unroll
            for (int m = 0; m < 4; ++m)
#pragma unroll
                for (int bj = 0; bj < 2; ++bj) { float* o = Y + (size_t)(row0 + ai * 128 + m * 16) * DM + cw + bj * 128; *(a4*)o = b[m][bj][0] + acc[ai][bj][m][0]; *(a4*)(o + 4) = b[m][bj][1] + acc[ai][bj][m][1]; }
        }
    }
};
__device__ __forceinline__ void wait_count(gu32* cnt, unsigned need) {
    unsigned spins = 0;
    while (__hip_atomic_load(cnt, __ATOMIC_RELAXED, __HIP_MEMORY_SCOPE_AGENT) < need) { __builtin_amdgcn_s_sleep(2); if (++spins > (1u << 22)) break; }
}
struct EpiDownF {
    static constexpr bool PERM = true, AFTER_DRAIN = true; static constexpr int MIDK = 0;
    const float* X1; float* Y; float* SS; gu32* cnt; const float* nw;
    __device__ __forceinline__ void operator()(const a4 (&acc)[2][2][4][2], const pg8::Unit& u, int wr, int wc, int fr, int fq) const {}
    __device__ __forceinline__ void fused(const a4 (&acc)[2][2][4][2], const pg8::Unit& u, int wr, int wc, int fr, int fq, LAS unsigned char* lds, int wid, int lane) const {
        const int row0 = u.pm * 256 + wr * 64 + fr, cw = u.pn * 256 + wc * 32 + 8 * fq;
#pragma unroll
        for (int ai = 0; ai < 2; ++ai) {
            a4 b[4][2][2];
#pragma unroll
            for (int m = 0; m < 4; ++m)
#pragma unroll
                for (int bj = 0; bj < 2; ++bj) { const GAS float* p = (const GAS float*)X1 + (size_t)(row0 + ai * 128 + m * 16) * DM + cw + bj * 128; b[m][bj][0] = *(const GAS a4*)p; b[m][bj][1] = *(const GAS a4*)(p + 4); }
#pragma unroll
            for (int m = 0; m < 4; ++m) { float ss = 0.f;
#pragma unroll
                for (int bj = 0; bj < 2; ++bj) { const a4 r0 = b[m][bj][0] + acc[ai][bj][m][0], r1 = b[m][bj][1] + acc[ai][bj][m][1];
                    ss += (r0[0] * r0[0] + r0[1] * r0[1]) + (r0[2] * r0[2] + r0[3] * r0[3]) + (r1[0] * r1[0] + r1[1] * r1[1]) + (r1[2] * r1[2] + r1[3] * r1[3]); }
                ss += __shfl_xor(ss, 16); ss += __shfl_xor(ss, 32);
                if (fq == 0) __hip_atomic_fetch_add(SS + (row0 + ai * 128 + m * 16), ss, __ATOMIC_RELAXED, __HIP_MEMORY_SCOPE_AGENT); }
        }
        asm volatile("s_waitcnt vmcnt(0)" ::: "memory");
        __syncthreads();
        if (threadIdx.x == 0) { __hip_atomic_fetch_add(cnt + 64 * u.pm, 1u, __ATOMIC_RELAXED, __HIP_MEMORY_SCOPE_AGENT); wait_count(cnt + 64 * u.pm, 4u); }
        __syncthreads();
        float rs[2][4];
#pragma unroll
        for (int ai = 0; ai < 2; ++ai)
#pragma unroll
            for (int m = 0; m < 4; ++m) rs[ai][m] = __hip_atomic_load(SS + (row0 + ai * 128 + m * 16), __ATOMIC_RELAXED, __HIP_MEMORY_SCOPE_AGENT);
        a4 w[2][2];
#pragma unroll
        for (int bj = 0; bj < 2; ++bj) { w[bj][0] = *(const GAS a4*)(nw + cw + bj * 128); w[bj][1] = *(const GAS a4*)(nw + cw + bj * 128 + 4); }
#pragma unroll
        for (int ai = 0; ai < 2; ++ai) {
            a4 b[4][2][2];
#pragma unroll
            for (int m = 0; m < 4; ++m)
#pragma unroll
                for (int bj = 0; bj < 2; ++bj) { const GAS float* p = (const GAS float*)X1 + (size_t)(row0 + ai * 128 + m * 16) * DM + cw + bj * 128; b[m][bj][0] = *(const GAS a4*)p; b[m][bj][1] = *(const GAS a4*)(p + 4); }
#pragma unroll
            for (int m = 0; m < 4; ++m) { const float r = 1.f / sqrtf(rs[ai][m] * (1.f / DM) + NORM_EPS);
#pragma unroll
                for (int bj = 0; bj < 2; ++bj) { float* o = Y + (size_t)(row0 + ai * 128 + m * 16) * DM + cw + bj * 128;
                    *(a4*)o = (b[m][bj][0] + acc[ai][bj][m][0]) * r * w[bj][0]; *(a4*)(o + 4) = (b[m][bj][1] + acc[ai][bj][m][1]) * r * w[bj][1]; } }
        }
    }
};
struct EpiUp {
    static constexpr bool PERM = true, AFTER_DRAIN = false; static constexpr int MIDK = 0;
    const float* SS; bf16* H;
    __device__ __forceinline__ void operator()(const a4 (&acc)[2][2][4][2], const pg8::Unit& u, int wr, int wc, int fr, int fq) const {
        float rs[2][4];
#pragma unroll
        for (int ai = 0; ai < 2; ++ai)
#pragma unroll
            for (int m = 0; m < 4; ++m) rs[ai][m] = __hip_atomic_load(SS + (u.pm * 256 + wr * 64 + fr + ai * 128 + m * 16), __ATOMIC_RELAXED, __HIP_MEMORY_SCOPE_AGENT);
#pragma unroll
        for (int ai = 0; ai < 2; ++ai)
#pragma unroll
            for (int m = 0; m < 4; ++m) rs[ai][m] = __builtin_amdgcn_rsqf(rs[ai][m] * (1.f / DM) + NORM_EPS);
        EPI_LOOP_BEGIN
            const float r = rs[ai][m];
#pragma unroll
            for (int e = 0; e < 4; ++e) { float a = fmaxf(v0[e] * r, 0.f), b = fmaxf(v1[e] * r, 0.f); v0[e] = a * a; v1[e] = b * b; }
            *(v4u*)(H + (size_t)row * FF + col) = pack8(v0, v1);
        EPI_LOOP_END
    }
};

__device__ __forceinline__ void p0_transpose_item(const float* W, int ldw, int nblk, bf16* WT, int ldt, int koff, const float* kscale, int shift_from, int shift, LAS float* scr, int item, int lane) {
    const int kb = item / nblk, nb = item % nblk, k0 = 64 * kb, n0 = 32 * nb, ns = n0 + (n0 >= shift_from ? shift : 0);
    const GAS float* Wg = (const GAS float*)W + (size_t)(k0 + (lane >> 5)) * ldw + ns + (lane & 31);
    float wv[32], sv[32];
#pragma unroll
    for (int i = 0; i < 32; ++i) wv[i] = Wg[(size_t)(2 * i) * ldw];
    if (kscale) {
#pragma unroll
        for (int i = 0; i < 32; ++i) sv[i] = ((const GAS float*)kscale)[k0 + 2 * i + (lane >> 5)];
#pragma unroll
        for (int i = 0; i < 32; ++i) wv[i] *= sv[i];
    }
#pragma unroll
    for (int i = 0; i < 32; ++i) scr[(2 * i + (lane >> 5)) * 33 + (lane & 31)] = wv[i];
    LDS_WAIT(); asm volatile("" ::: "memory");
    const int c = lane & 7;
#pragma unroll
    for (int j = 0; j < 4; ++j) { const int n = (lane >> 3) + 8 * j; const LAS float* s = scr + (8 * c) * 33 + n;
        v4u o; o.x = pk2(s[0 * 33], s[1 * 33]); o.y = pk2(s[2 * 33], s[3 * 33]); o.z = pk2(s[4 * 33], s[5 * 33]); o.w = pk2(s[6 * 33], s[7 * 33]);
        *(GAS v4u*)(WT + (size_t)(n0 + n) * ldt + koff + k0 + 8 * c) = o; }
    LDS_WAIT(); asm volatile("" ::: "memory");
}
__device__ __forceinline__ void p0_prologue(Frame& F, unsigned long long& ts_mid) {
    LAS float* scr = (LAS float*)(F.lds + RING_OFF + F.wave * 12288);
    const int gw = F.vcu * NWAVES + F.wave, NGW = F.G * NWAVES, lane = F.lane;
    constexpr int I_IN = (DM / 64) * (NIN / 32), I_PA = (512 / 64) * (DM / 32), I_O = (DM / 64) * (DM / 32), I_UP = (DM / 64) * (FF / 32), I_DN = (FF / 64) * (DM / 32);
    constexpr int NITEMS = I_IN + 2 * I_PA + I_O + I_UP + I_DN;
    for (int it = gw; it < NITEMS; it += NGW) {
        int r = it;
        if (r < I_IN) { p0_transpose_item(F.w_in, INW, NIN / 32, WSP(bf16, WS_WIN), DM, 0, F.norm_mix_w, 3584, 8, scr, r, lane); continue; } r -= I_IN;
        if (r < I_PA) { p0_transpose_item(F.w_pa, DM, DM / 32, WSP(bf16, WS_WCAT), DM, 0, nullptr, 1 << 30, 0, scr, r, lane); continue; } r -= I_PA;
        if (r < I_PA) { p0_transpose_item(F.w_pb, DM, DM / 32, WSP(bf16, WS_WCAT), DM, 512, nullptr, 1 << 30, 0, scr, r, lane); continue; } r -= I_PA;
        if (r < I_O) { p0_transpose_item(F.w_o, DM, DM / 32, WSP(bf16, WS_WO), DM, 0, nullptr, 1 << 30, 0, scr, r, lane); continue; } r -= I_O;
        if (r < I_UP) { p0_transpose_item(F.w_up, FF, FF / 32, WSP(bf16, WS_WUP), DM, 0, F.norm_mlp_w, 1 << 30, 0, scr, r, lane); continue; } r -= I_UP;
        p0_transpose_item(F.w_down, DM, DM / 32, WSP(bf16, WS_WDN), FF, 0, nullptr, 1 << 30, 0, scr, r, lane);
    }
    __syncthreads();
    if (PROBE_WAIT_PHASE == 200 || PROBE_WAIT_PHASE == 201) ts_mid = __builtin_amdgcn_s_memrealtime();
    {
        LAS f32x4* wl = (LAS f32x4*)(F.lds + RING_OFF + 98304);
#pragma unroll
        for (int i = 0; i < 2; ++i) { const int k = F.tid + 512 * i; const float nw = F.norm_mix_w[k]; const float* wp = F.w_in + (size_t)k * INW + 3584;
            wl[2 * k] = *(const f32x4*)wp * nw; wl[2 * k + 1] = *(const f32x4*)(wp + 4) * nw; }
    }
    __syncthreads();
    f32x4 wab[4][4][2];
#pragma unroll
    for (int jj = 0; jj < 4; ++jj)
#pragma unroll
        for (int e = 0; e < 4; ++e) { const int k = 256 * jj + 4 * lane + e; const LAS f32x4* wl = (const LAS f32x4*)(F.lds + RING_OFF + 98304);
            wab[jj][e][0] = wl[2 * k]; wab[jj][e][1] = wl[2 * k + 1]; }
    bf16* XN = WSP(bf16, WS_XN); float* AB = WSP(float, WS_AB);
#define P0_XROW(m) ((const GAS f32x4*)((m) < MP ? F.xp + (size_t)(m) * DM : F.xs + (size_t)((m) - MP) * DM) + lane)
    f32x4 vn[4];
    if (gw < M) {
#pragma unroll
        for (int j = 0; j < 4; ++j) vn[j] = P0_XROW(gw)[64 * j]; }
    for (int m = gw; m < M; m += NGW) {
        f32x4 v[4]; float s = 0.f;
#pragma unroll
        for (int j = 0; j < 4; ++j) v[j] = vn[j];
        if (m + NGW < M) {
#pragma unroll
            for (int j = 0; j < 4; ++j) vn[j] = P0_XROW(m + NGW)[64 * j]; }
#pragma unroll
        for (int j = 0; j < 4; ++j) s += (v[j].x * v[j].x + v[j].y * v[j].y) + (v[j].z * v[j].z + v[j].w * v[j].w);
        const float rstd = 1.f / sqrtf(wave_sum(s) * (1.f / DM) + NORM_EPS);
        GAS unsigned long long* o8 = (GAS unsigned long long*)(XN + (size_t)m * DM) + lane;
        f32x4 d0 = {0.f, 0.f, 0.f, 0.f}, d1 = {0.f, 0.f, 0.f, 0.f};
#pragma unroll
        for (int j = 0; j < 4; ++j) { v[j] = v[j] * rstd;
            o8[64 * j] = (unsigned long long)pk2(v[j].x, v[j].y) | ((unsigned long long)pk2(v[j].z, v[j].w) << 32);
#pragma unroll
            for (int e = 0; e < 4; ++e) { d0 += wab[j][e][0] * v[j][e]; d1 += wab[j][e][1] * v[j][e]; } }
        { float t[8] = {d0[0], d0[1], d0[2], d0[3], d1[0], d1[1], d1[2], d1[3]};
          const bool u5 = lane & 32, u4 = lane & 16, u3 = lane & 8;
          float a[4];
#pragma unroll
          for (int i = 0; i < 4; ++i) { const float keep = u5 ? t[4 + i] : t[i], give = u5 ? t[i] : t[4 + i]; a[i] = keep + __shfl_xor(give, 32); }
          float b2[2];
#pragma unroll
          for (int i = 0; i < 2; ++i) { const float keep = u4 ? a[2 + i] : a[i], give = u4 ? a[i] : a[2 + i]; b2[i] = keep + __shfl_xor(give, 16); }
          float c1; { const float keep = u3 ? b2[1] : b2[0], give = u3 ? b2[0] : b2[1]; c1 = keep + __shfl_xor(give, 8); }
          c1 += __shfl_xor(c1, 4); c1 += __shfl_xor(c1, 2); c1 += __shfl_xor(c1, 1);
          if ((lane & 7) == 0) AB[(size_t)m * 8 + ((lane >> 5) & 1) * 4 + ((lane >> 4) & 1) * 2 + ((lane >> 3) & 1)] = c1; }
    }
#undef P0_XROW
}

__device__ __forceinline__ void p2_gdn_prep(Frame& F) {
    const int gw = F.vcu * NWAVES + F.wave, NGW = F.G * NWAVES, lane = F.lane;
    const float* U = WSP(float, WS_U); float* QKVN = WSP(float, WS_QKVN); const float* AB = WSP(float, WS_AB); float* GBETA = WSP(float, WS_GBETA);
    typedef float f2 __attribute__((ext_vector_type(2)));
    for (int it = MP * GH + gw; it < M * GH; it += NGW) {
        const int row = it >> 2, h = it & 3;
        int t, seq; bool prompt = row < MP; if (prompt) { seq = row / TP; t = row % TP; } else { seq = (row - MP) >> 2; t = (row - MP) & 3; }
        f2 cv[3];
#pragma unroll
        for (int p = 0; p < 3; ++p) {
            const int ch = p * 512 + h * 128 + 2 * lane; f2 acc = {0.f, 0.f};
#pragma unroll
            for (int w = 0; w < 4; ++w) {
                const int tt = t - 3 + w; f2 uv;
                if (tt >= 0) uv = *(const f2*)(U + (size_t)(row - 3 + w) * CONVD + ch);
                else if (prompt) uv = (f2){0.f, 0.f};
                else uv = *(const f2*)(F.state_conv + ((size_t)seq * 3 + (tt + 3)) * CONVD + ch);
                const f2 cw = *(const f2*)(F.conv_w + (size_t)w * CONVD + ch);
                acc += uv * cw;
            }
            acc.x = acc.x * sigmoidf_(acc.x); acc.y = acc.y * sigmoidf_(acc.y);
            cv[p] = acc;
            const int tl = prompt ? TP : TS;
            if (t >= tl - 3) { const f2 uv = *(const f2*)(U + (size_t)row * CONVD + ch); const int i = t - (tl - 3);
                float* o = F.out + (prompt ? O_CP + ((size_t)seq * 3 + i) * CONVD : O_CS + ((size_t)seq * 3 + i) * CONVD) + ch; *(f2*)o = uv; }
        }
        const float sq = wave_sum(cv[0].x * cv[0].x + cv[0].y * cv[0].y), sk = wave_sum(cv[1].x * cv[1].x + cv[1].y * cv[1].y);
        const float rq = __builtin_amdgcn_rsqf(sq + L2_EPS) * 0.08838834764831845f, rk = __builtin_amdgcn_rsqf(sk + L2_EPS);
        float* o = QKVN + (size_t)row * CONVD + h * 128 + 2 * lane;
        *(f2*)o = cv[0] * rq; *(f2*)(o + 512) = cv[1] * rk; *(f2*)(o + 1024) = cv[2];
        if (lane == 0) { const float a = AB[(size_t)row * 8 + h] + F.dt_bias[h], b = AB[(size_t)row * 8 + 4 + h];
            const float sp = a > 20.f ? a : log1pf(__expf(a));
            GBETA[(size_t)row * 8 + h] = -__expf(F.a_log[h]) * sp; GBETA[(size_t)row * 8 + 4 + h] = sigmoidf_(b); }
    }
}


__device__ __forceinline__ void conv_rows8(Frame& F, size_t row0, int t0, int seq, int h, int lane, LAS unsigned char* img  , LAS float* scc, int lr0  ) {
    typedef float f2 __attribute__((ext_vector_type(2)));
    const float* U = WSP(float, WS_U); float* QKVN = WSP(float, WS_QKVN); const float* AB = WSP(float, WS_AB); float* GBETA = WSP(float, WS_GBETA);
    float ga = 0.f, gb = 0.f;
    if (lane < 8) { ga = AB[(row0 + lane) * 8 + h] + F.dt_bias[h]; gb = AB[(row0 + lane) * 8 + 4 + h]; }
#pragma unroll
    for (int p = 0; p < 3; ++p) {
        const int ch = p * 512 + h * 128 + 2 * lane;
        f2 u[11], cw[4];
#pragma unroll
        for (int i = 0; i < 11; ++i) u[i] = *(const GAS f2*)(U + (row0 + i >= 3 ? row0 + i - 3 : 0) * CONVD + ch);
#pragma unroll
        for (int i = 0; i < 3; ++i) if (t0 - 3 + i < 0) u[i] = (f2){0.f, 0.f};
#pragma unroll
        for (int w = 0; w < 4; ++w) cw[w] = *(const f2*)(F.conv_w + (size_t)w * CONVD + ch);
#pragma unroll
        for (int r = 0; r < 8; ++r) {
            f2 acc = u[r] * cw[0] + u[r + 1] * cw[1] + u[r + 2] * cw[2] + u[r + 3] * cw[3];
            acc.x = acc.x * sigmoidf_(acc.x); acc.y = acc.y * sigmoidf_(acc.y);
            float sc = 1.f;
            if (p < 2) { const float ss = wave_sum(acc.x * acc.x + acc.y * acc.y); sc = __builtin_amdgcn_rsqf(ss + L2_EPS) * (p == 0 ? 0.08838834764831845f : 1.f); }
            { const f2 y = acc * sc; *(LAS unsigned*)(img + (p == 0 ? 17408 : p == 1 ? 0 : 104448) + (lr0 + r) * 272 + 4 * lane) = pg8::cvt_pk_bf16(y.x, y.y); }
            if (t0 + r >= TP - 3) *(f2*)(F.out + O_CP + ((size_t)seq * 3 + (t0 + r - (TP - 3))) * CONVD + ch) = u[r + 3];
        }
    }
    if (lane < 8) { const float sp = ga > 20.f ? ga : log1pf(__expf(ga));
        scc[lr0 + lane] = -__expf(F.a_log[h]) * sp; scc[64 + lr0 + lane] = sigmoidf_(gb); }
}
__device__ __forceinline__ unsigned long long gdn_pk4(float a, float b, float c, float d) { return (unsigned long long)pg8::cvt_pk_bf16(a, b) | ((unsigned long long)pg8::cvt_pk_bf16(c, d) << 32); }
namespace sba {
typedef float f32x16 __attribute__((ext_vector_type(16)));
typedef short s16x4 __attribute__((ext_vector_type(4)));
typedef short v4i16_t __attribute__((ext_vector_type(4)));
typedef __attribute__((address_space(3))) const unsigned char* lptr;
constexpr int SLOTB = 8192;
constexpr int L_K = 0, L_V = 4 * SLOTB, L_STG = 8 * SLOTB, L_END = L_STG + NWAVES * 4096;

__device__ __forceinline__ s16x4 vtr(lptr p) { return __builtin_bit_cast(s16x4, __builtin_amdgcn_ds_read_tr16_b64_v4i16((__attribute__((address_space(3))) v4i16_t*)p)); }
__device__ __forceinline__ bf16x8 pack8f(float a, float b, float c, float d, float e, float f, float g, float h) {
    v4u w; w.x = pg8::cvt_pk_bf16(a, b); w.y = pg8::cvt_pk_bf16(c, d); w.z = pg8::cvt_pk_bf16(e, f); w.w = pg8::cvt_pk_bf16(g, h); return __builtin_bit_cast(bf16x8, w); }

__device__ __forceinline__ float mulv(float a, float b) { float r; asm("v_mul_f32_e32 %0, %1, %2" : "=v"(r) : "v"(a), "v"(b)); return r; }
#define HZ_FENCE8(x, o) asm volatile("s_nop 1" : "+v"(x[o]), "+v"(x[o + 1]), "+v"(x[o + 2]), "+v"(x[o + 3]), "+v"(x[o + 4]), "+v"(x[o + 5]), "+v"(x[o + 6]), "+v"(x[o + 7]))
#define HZ_FENCE16(x) asm volatile("s_nop 1" : "+v"(x[0]), "+v"(x[1]), "+v"(x[2]), "+v"(x[3]), "+v"(x[4]), "+v"(x[5]), "+v"(x[6]), "+v"(x[7]), "+v"(x[8]), "+v"(x[9]), "+v"(x[10]), "+v"(x[11]), "+v"(x[12]), "+v"(x[13]), "+v"(x[14]), "+v"(x[15]))
template <int NB, bool MASK> __device__ __forceinline__ void weights(f32x16 (&p)[NB], float& R, int hi, int lim) {
    float om[NB][16];
    const int lim0 = lim - 4 * hi;
#pragma unroll
    for (int blk = 0; blk < NB; ++blk)
#pragma unroll
        for (int r = 0; r < 16; ++r) {
            const int c = (r & 3) + 8 * (r >> 2) + 32 * blk;
            float z = p[blk][r];
            if (MASK) { if (!(c < lim0)) z = -INFINITY; }
            const float e = __builtin_amdgcn_exp2f(z);
            om[blk][r] = __builtin_amdgcn_rcpf(1.f + e);
            p[blk][r] = e;
        }
#pragma unroll
    for (int blk = 0; blk < NB; ++blk) { HZ_FENCE16(om[blk]); HZ_FENCE16(p[blk]); }
    float G[4 * NB], sel[4 * NB], A[4 * NB], B[4 * NB];
#pragma unroll
    for (int k = 0; k < 4 * NB; ++k) { const int blk = k >> 2, g = k & 3; float t;
        asm("v_mul_f32_e32 %0, %2, %3\n\tv_mul_f32_e32 %1, %4, %5\n\tv_mul_f32_e32 %0, %0, %1" : "=&v"(G[k]), "=&v"(t) : "v"(om[blk][4 * g]), "v"(om[blk][4 * g + 1]), "v"(om[blk][4 * g + 2]), "v"(om[blk][4 * g + 3])); }
    if constexpr (NB == 2) HZ_FENCE8(G, 0);
    if constexpr (NB == 1) asm volatile("s_nop 1" : "+v"(G[0]), "+v"(G[1]), "+v"(G[2]), "+v"(G[3]));
#pragma unroll
    for (int k = 0; k < 4 * NB; ++k) { auto rr = __builtin_amdgcn_permlane32_swap(__float_as_uint(G[k]), __float_as_uint(G[k]), false, false);
        A[k] = __uint_as_float(rr[0]); B[k] = __uint_as_float(rr[1]); }
    if constexpr (NB == 2) asm volatile("s_nop 1" : "+v"(A[0]), "+v"(A[1]), "+v"(A[2]), "+v"(A[3]), "+v"(A[4]), "+v"(A[5]), "+v"(A[6]), "+v"(A[7]), "+v"(B[0]), "+v"(B[1]), "+v"(B[2]), "+v"(B[3]), "+v"(B[4]), "+v"(B[5]), "+v"(B[6]), "+v"(B[7]));
    if constexpr (NB == 1) { asm volatile("s_nop 1" : "+v"(A[0]), "+v"(A[1]), "+v"(A[2]), "+v"(A[3]), "+v"(B[0]), "+v"(B[1]), "+v"(B[2]), "+v"(B[3])); }
#pragma unroll
    for (int k = 0; k < 4 * NB; ++k) sel[k] = hi ? 1.f : B[k];
    float E = R;
#pragma unroll
    for (int k = 4 * NB - 1; k >= 0; --k) {
        const int blk = k >> 2, r0 = 4 * (k & 3); float P;
        asm("v_mul_f32_e32 %0, %5, %6\n\t"
            "v_mul_f32_e32 %0, %0, %10\n\tv_mul_f32_e32 %4, %4, %0\n\t"
            "v_mul_f32_e32 %0, %0, %9\n\tv_mul_f32_e32 %3, %3, %0\n\t"
            "v_mul_f32_e32 %0, %0, %8\n\tv_mul_f32_e32 %2, %2, %0\n\t"
            "v_mul_f32_e32 %0, %0, %7\n\tv_mul_f32_e32 %1, %1, %0\n\t"
            "v_mul_f32_e32 %5, %5, %11\n\tv_mul_f32_e32 %5, %5, %12"
            : "=&v"(P), "+v"(p[blk][r0]), "+v"(p[blk][r0 + 1]), "+v"(p[blk][r0 + 2]), "+v"(p[blk][r0 + 3]), "+v"(E)
            : "v"(sel[k]), "v"(om[blk][r0]), "v"(om[blk][r0 + 1]), "v"(om[blk][r0 + 2]), "v"(om[blk][r0 + 3]), "v"(A[k]), "v"(B[k]));
    }
    R = E;
}
template <int NB, int KS, int CS, int VDH, int MODE  > __device__ __forceinline__ void tile(f32x16 (&o)[2], float& R, const bf16x8 (&qr)[4], lptr Ks, lptr Vs, float bias2, int lane, int lim) {
    const int r32 = lane & 31, hi = lane >> 5;
    f32x16 p[NB];
#pragma unroll
    for (int blk = 0; blk < NB; ++blk)
#pragma unroll
        for (int r = 0; r < 16; ++r) p[blk][r] = bias2;
    lptr kb = Ks + r32 * KS + hi * CS;
#pragma unroll
    for (int d0 = 0; d0 < 4; ++d0)
#pragma unroll
        for (int blk = 0; blk < NB; ++blk) p[blk] = __builtin_amdgcn_mfma_f32_32x32x16_bf16(*(const __attribute__((address_space(3))) bf16x8*)(kb + 2 * d0 * CS + 32 * blk * KS), qr[d0], p[blk], 0, 0, 0);
    weights<NB, MODE == 1>(p, R, hi, lim);
    lptr vp = Vs + ((lane >> 4) & 1) * 32 + (lane & 3) * 8 + (4 * hi + ((lane & 15) >> 2)) * 64;
#pragma unroll
    for (int blk = 0; blk < NB; ++blk)
#pragma unroll
        for (int s2 = 0; s2 < 2; ++s2) { const int s = 2 * blk + s2;
            const bf16x8 pa = pack8f(p[blk][8 * s2], p[blk][8 * s2 + 1], p[blk][8 * s2 + 2], p[blk][8 * s2 + 3], p[blk][8 * s2 + 4], p[blk][8 * s2 + 5], p[blk][8 * s2 + 6], p[blk][8 * s2 + 7]);
#pragma unroll
            for (int d0 = 0; d0 < 2; ++d0) { const s16x4 lo = vtr(vp + d0 * VDH + s * 1024), hh = vtr(vp + d0 * VDH + s * 1024 + 512);
                const bf16x8 vf = {lo[0], lo[1], lo[2], lo[3], hh[0], hh[1], hh[2], hh[3]};
                o[d0] = __builtin_amdgcn_mfma_f32_32x32x16_bf16(pa, vf, o[d0], 0, 0, 0); } }
}
__device__ __forceinline__ void qk2(f32x16 (&p)[2], const bf16x8 (&qr)[4], lptr Ks, float bias2, int lane) {
    const int r32 = lane & 31, hi = lane >> 5;
#pragma unroll
    for (int blk = 0; blk < 2; ++blk)
#pragma unroll
        for (int r = 0; r < 16; ++r) p[blk][r] = bias2;
    lptr kb = Ks + r32 * 16 + hi * 1024;
#pragma unroll
    for (int d0 = 0; d0 < 4; ++d0)
#pragma unroll
        for (int blk = 0; blk < 2; ++blk) p[blk] = __builtin_amdgcn_mfma_f32_32x32x16_bf16(*(const __attribute__((address_space(3))) bf16x8*)(kb + 2 * d0 * 1024 + 32 * blk * 16), qr[d0], p[blk], 0, 0, 0);
}
__device__ __forceinline__ void wpv2(f32x16 (&o)[2], float& R, f32x16 (&p)[2], lptr Vs, int lane) {
    const int hi = lane >> 5;
    weights<2, false>(p, R, hi, 64);
    lptr vp = Vs + ((lane >> 4) & 1) * 32 + (lane & 3) * 8 + (4 * hi + ((lane & 15) >> 2)) * 64;
#pragma unroll
    for (int blk = 0; blk < 2; ++blk)
#pragma unroll
        for (int s2 = 0; s2 < 2; ++s2) { const int s = 2 * blk + s2;
            const bf16x8 pa = pack8f(p[blk][8 * s2], p[blk][8 * s2 + 1], p[blk][8 * s2 + 2], p[blk][8 * s2 + 3], p[blk][8 * s2 + 4], p[blk][8 * s2 + 5], p[blk][8 * s2 + 6], p[blk][8 * s2 + 7]);
#pragma unroll
            for (int d0 = 0; d0 < 2; ++d0) { const s16x4 lo = vtr(vp + d0 * 4096 + s * 1024), hh = vtr(vp + d0 * 4096 + s * 1024 + 512);
                const bf16x8 vf = {lo[0], lo[1], lo[2], lo[3], hh[0], hh[1], hh[2], hh[3]};
                o[d0] = __builtin_amdgcn_mfma_f32_32x32x16_bf16(pa, vf, o[d0], 0, 0, 0); } }
}
#define SBA_WAITBAR() asm volatile("s_waitcnt vmcnt(0) lgkmcnt(0)\n\ts_barrier" ::: "memory")
__device__ __forceinline__ void prompt_unit(LAS unsigned char* L, const bf16* Qa, const bf16* Ka, const bf16* Va, bf16* Ocat, float bias2, int b, int h, int qb, int wid, int lane) {
    const int r32 = lane & 31, hi = lane >> 5, q0 = qb * 256, NT = 4 * qb + 4;
    const size_t rowb = (size_t)b * TP;
    const bf16* Kh = Ka + rowb * 512 + h * 64; const bf16* Vh = Va + rowb * 512 + h * 64;
    const bf16* ksrc = Kh + (size_t)lane * 512 + wid * 8;
    const bf16* vsrc = Vh + (size_t)(16 * (wid & 3) + (lane >> 2)) * 512 + (wid >> 2) * 32 + (lane & 3) * 8;
#define SBA_DMA1(kt, off) do { __builtin_amdgcn_global_load_lds((const unsigned*)(ksrc + (size_t)(kt) * 64 * 512), (LAS unsigned*)(L + L_K + (off) + wid * 1024), 16, 0, 0); \
                                __builtin_amdgcn_global_load_lds((const unsigned*)(vsrc + (size_t)(kt) * 64 * 512), (LAS unsigned*)(L + L_V + (off) + wid * 1024), 16, 0, 0); } while (0)
#define SBA_DMA(kp, slot) do { SBA_DMA1(2 * (kp) + 1, (slot) * 2 * SLOTB); SBA_DMA1(2 * (kp), (slot) * 2 * SLOTB + SLOTB); } while (0)
    int kp = NT / 2 - 1;
    SBA_DMA(kp, 0);
    bf16x8 qr[4];
    const bf16* Qw = Qa + (rowb + q0 + wid * 32 + r32) * 512 + h * 64 + hi * 8;
#pragma unroll
    for (int d0 = 0; d0 < 4; ++d0) qr[d0] = *(const bf16x8*)(Qw + d0 * 16);
    f32x16 o[2];
#pragma unroll
    for (int r = 0; r < 16; ++r) { o[0][r] = 0.f; o[1][r] = 0.f; }
    float R = 1.f;
    const int trel = wid * 32 + r32;
    SBA_WAITBAR();
    int slot = 0;
    for (; kp >= NT / 2 - 2; --kp) {
        if (kp > 0) SBA_DMA(kp - 1, slot ^ 1);
#pragma unroll
        for (int sub = 0; sub < 2; ++sub) { const int kt = 2 * kp + 1 - sub, k0rel = 64 * kt - q0;
            if (k0rel < wid * 32 + 31) tile<2, 16, 1024, 4096, 1>(o, R, qr, (lptr)(L + L_K + (slot * 2 + sub) * SLOTB), (lptr)(L + L_V + (slot * 2 + sub) * SLOTB), bias2, lane, trel - k0rel); }
        SBA_WAITBAR();
        slot ^= 1;
    }
    for (; kp >= 0; --kp) {
        if (kp > 0) SBA_DMA(kp - 1, slot ^ 1);
        { f32x16 pA[2], pB[2];
          qk2(pA, qr, (lptr)(L + L_K + slot * 2 * SLOTB), bias2, lane);
          qk2(pB, qr, (lptr)(L + L_K + (slot * 2 + 1) * SLOTB), bias2, lane);
          wpv2(o, R, pA, (lptr)(L + L_V + slot * 2 * SLOTB), lane);
          wpv2(o, R, pB, (lptr)(L + L_V + (slot * 2 + 1) * SLOTB), lane); }
        SBA_WAITBAR();
        slot ^= 1;
    }
    LAS bf16* stg = (LAS bf16*)(L + L_STG + wid * 4096);
#pragma unroll
    for (int r = 0; r < 16; ++r) { const int orow = (r & 3) + 8 * (r >> 2) + 4 * hi;
        stg[orow * 64 + r32] = (bf16)(pg8::cvt_pk_bf16(o[0][r], 0.f) & 0xffffu); stg[orow * 64 + 32 + r32] = (bf16)(pg8::cvt_pk_bf16(o[1][r], 0.f) & 0xffffu); }
    asm volatile("s_waitcnt lgkmcnt(0)" ::: "memory");
    bf16* Ow = Ocat + (rowb + q0 + wid * 32) * DM + h * 64;
#pragma unroll
    for (int i = 0; i < 4; ++i) { const int row = i * 8 + (lane >> 3), ch = lane & 7; *(v4u*)(Ow + (size_t)row * DM + ch * 8) = *(const LAS v4u*)(stg + row * 64 + ch * 8); }
    asm volatile("s_waitcnt lgkmcnt(0)\n\ts_barrier" ::: "memory");
#undef SBA_DMA
#undef SBA_DMA1
}

constexpr int SNC = 4, SCH = PAST / SNC;
__device__ __forceinline__ void sample_wave_unit(LAS unsigned char* Lw, const bf16* Qa, const float* cache_k, const float* cache_v, const int* page_table, const float* outp, float* PO, float* PR,
                                                 float bias2, int s, int h, int c, int lane) {
    const int r32 = lane & 31, hi = lane >> 5, key16 = lane >> 4, c16 = lane & 15;
    LAS unsigned char* Kimg = Lw; LAS unsigned char* Vimg = Lw + 4608;
    bf16x8 qr[4];
#pragma unroll
    for (int d0 = 0; d0 < 4; ++d0) { qr[d0] = (bf16x8){0, 0, 0, 0, 0, 0, 0, 0}; if (r32 < 4) qr[d0] = *(const bf16x8*)(Qa + ((size_t)MP + 4 * s + r32) * 512 + h * 64 + 16 * d0 + 8 * hi); }
    f32x16 o[2];
#pragma unroll
    for (int r = 0; r < 16; ++r) { o[0][r] = 0.f; o[1][r] = 0.f; }
    float R = 1.f;
    a4 kr[8], vr[8];
    const int kt_hi = (c * SCH + SCH) / 32 - 1, kt_lo = c * SCH / 32;
    const bool top = (c == SNC - 1);
#define SMP_LOAD(kt) do { if ((kt) > kt_hi) { const size_t off = ((size_t)4 * s + key16) * 512 + h * 64 + c16 * 4; kr[0] = *(const a4*)(outp + O_KS + off); vr[0] = *(const a4*)(outp + O_VS + off); \
            _Pragma("unroll") for (int i = 1; i < 8; ++i) { kr[i] = (a4){0.f, 0.f, 0.f, 0.f}; vr[i] = (a4){0.f, 0.f, 0.f, 0.f}; } } \
        else { const int key0 = 32 * (kt), pg = page_table[s * NPAGES + (key0 >> 7)]; const size_t off = (((size_t)pg * PAGE + (key0 & 127) + key16) * SBH + h) * 64 + c16 * 4; \
            _Pragma("unroll") for (int i = 0; i < 8; ++i) { kr[i] = *(const a4*)(cache_k + off + (size_t)i * 4 * 512); vr[i] = *(const a4*)(cache_v + off + (size_t)i * 4 * 512); } } } while (0)
    int kt = top ? kt_hi + 1 : kt_hi;
    SMP_LOAD(kt);
    for (; kt >= kt_lo; --kt) {
#pragma unroll
        for (int i = 0; i < 8; ++i) { const int key = 4 * i + key16;
            *(LAS unsigned long long*)(Kimg + key * 144 + c16 * 8) = gdn_pk4(kr[i][0], kr[i][1], kr[i][2], kr[i][3]);
            *(LAS unsigned long long*)(Vimg + (c16 >> 3) * 2048 + (key >> 3) * 512 + (key & 7) * 64 + (c16 & 7) * 8) = gdn_pk4(vr[i][0], vr[i][1], vr[i][2], vr[i][3]); }
        const bool isnew = kt > kt_hi;
        if (kt > kt_lo) SMP_LOAD(kt - 1);
        if (isnew) tile<1, 144, 16, 2048, 1>(o, R, qr, (lptr)Kimg, (lptr)Vimg, bias2, lane, r32);
        else tile<1, 144, 16, 2048, 0>(o, R, qr, (lptr)Kimg, (lptr)Vimg, bias2, lane, 32);
    }
#undef SMP_LOAD
    const size_t u = ((size_t)(s * SBH + h)) * SNC + c;
    if (hi == 0) {
#pragma unroll
        for (int r = 0; r < 4; ++r) { PO[u * 256 + r * 64 + r32] = o[0][r]; PO[u * 256 + r * 64 + 32 + r32] = o[1][r]; }
        if (r32 < 4) PR[u * 4 + r32] = R;
    }
}
}

__device__ __forceinline__ void attn_sample_naive(Frame& F, int sq) {
    const bf16* Qa = WSP(bf16, WS_QA); bf16* Ocat = WSP(bf16, WS_OCAT);
    LAS float* Ks = (LAS float*)(F.lds + RING_OFF); LAS float* Vs = Ks + 8192;
    const int tid = F.tid;
    {
        const int h = (tid >> 2) & 7, j = tid & 3; const size_t row = (size_t)MP + sq * 4 + j;
        const float bias2 = F.sb_bias[h] * LOG2E;
        float q[64], o[64];
#pragma unroll
        for (int d = 0; d < 64; d += 8) { a4 v0, v1; unpack8(*(const v4u*)(Qa + row * 512 + h * 64 + d), v0, v1);
#pragma unroll
            for (int e = 0; e < 4; ++e) { q[d + e] = v0[e]; q[d + 4 + e] = v1[e]; } }
#pragma unroll
        for (int d = 0; d < 64; ++d) o[d] = 0.f;
        float prod = 1.f;
        for (int kt = 128; kt >= 0; --kt) {
            __syncthreads();
#pragma unroll
            for (int i = 0; i < 4; ++i) { const int f = tid + i * 512, r = f >> 7, c4 = (f & 127) * 4;
                const float *kp, *vp; bool ok = true;
                if (kt == 128) { ok = r < 4; kp = F.out + O_KS + (size_t)(sq * 4 + (r & 3)) * 512 + c4; vp = F.out + O_VS + (size_t)(sq * 4 + (r & 3)) * 512 + c4; }
                else { const int key = kt * 16 + r, pg = F.page_table[sq * NPAGES + (key >> 7)]; const size_t off = ((size_t)pg * PAGE + (key & 127)) * 512 + c4; kp = F.cache_k + off; vp = F.cache_v + off; }
                if (ok) { *(LAS a4*)(Ks + r * 512 + c4) = *(const a4*)kp; *(LAS a4*)(Vs + r * 512 + c4) = *(const a4*)vp; } }
            __syncthreads();
            if (tid < 32) {
                for (int s = (kt == 128 ? 3 : 15); s >= 0; --s) {
                    const bool valid = (kt < 128) || (s < j);
                    float z = bias2;
#pragma unroll
                    for (int d = 0; d < 64; d += 4) { const a4 kv = *(const LAS a4*)(Ks + s * 512 + h * 64 + d); z += q[d] * kv[0] + q[d + 1] * kv[1] + q[d + 2] * kv[2] + q[d + 3] * kv[3]; }
                    const float e = __builtin_amdgcn_exp2f(z), r = __builtin_amdgcn_rcpf(1.f + e);
                    const float w = valid ? e * r * prod : 0.f;
                    if (valid) prod *= r;
#pragma unroll
                    for (int d = 0; d < 64; d += 4) { const a4 vv = *(const LAS a4*)(Vs + s * 512 + h * 64 + d); o[d] += w * vv[0]; o[d + 1] += w * vv[1]; o[d + 2] += w * vv[2]; o[d + 3] += w * vv[3]; }
                }
            }
        }
        if (tid < 32) {
#pragma unroll
            for (int d = 0; d < 64; d += 8) { a4 v0 = {o[d], o[d + 1], o[d + 2], o[d + 3]}, v1 = {o[d + 4], o[d + 5], o[d + 6], o[d + 7]}; *(v4u*)(Ocat + row * DM + h * 64 + d) = pack8(v0, v1); }
        }
    }
    __syncthreads();
}
constexpr int CW_Q3 = 2048;
__device__ __forceinline__ void gdn_naive_unit(Frame& F, int un) {
    const float* QKVN = WSP(float, WS_QKVN); const float* GBETA = WSP(float, WS_GBETA); float* ORAW = WSP(float, WS_ORAW);
    LAS float* Ls = (LAS float*)(F.lds + RING_OFF);
    const int tid = F.tid, c = tid >> 2, rq = tid & 3;
    {
        const bool prompt = un < NBP * GH; int seq, h, T; size_t row0; const float* s0; float* sout;
        if (prompt) { seq = un / GH; h = un % GH; T = TP; row0 = (size_t)seq * TP; s0 = nullptr; sout = F.out + O_SP + (size_t)(seq * GH + h) * GD * GD; }
        else { const int v = un - NBP * GH; seq = v / GH; h = v % GH; T = TS; row0 = (size_t)MP + seq * TS; s0 = F.state_ssm + (size_t)(seq * GH + h) * GD * GD; sout = F.out + O_SS + (size_t)(seq * GH + h) * GD * GD; }
        float S[32];
#pragma unroll
        for (int i = 0; i < 32; ++i) S[i] = 0.f;
    if (s0) {
#pragma unroll
        for (int i = 0; i < 32; ++i) S[i] = ((const GAS float*)s0)[(size_t)(rq * 32 + i) * GD + c]; }
        for (int t0 = 0; t0 < T; t0 += 16) {
            const int nt = (T - t0) < 16 ? (T - t0) : 16;
            __syncthreads();
            for (int f = tid; f < nt * 96; f += NTHR) { const int r = f / 96, q4 = f % 96, part = q4 / 32, c4 = (q4 % 32) * 4;
                *(LAS a4*)(Ls + r * 384 + part * 128 + c4) = *(const a4*)(QKVN + (row0 + t0 + r) * CONVD + part * 512 + h * 128 + c4); }
            if (tid < nt) { Ls[6144 + 2 * tid] = GBETA[(row0 + t0 + tid) * 8 + h]; Ls[6144 + 2 * tid + 1] = GBETA[(row0 + t0 + tid) * 8 + 4 + h]; }
            __syncthreads();
            for (int r = 0; r < nt; ++r) {
                const LAS float* qv = Ls + r * 384 + rq * 32; const LAS float* kv = qv + 128; const float vv = Ls[r * 384 + 256 + c];
                const float eg = __expf(Ls[6144 + 2 * r]), beta = Ls[6144 + 2 * r + 1];
                float kk[32]; float ks = 0.f;
#pragma unroll
                for (int i = 0; i < 32; i += 4) { const a4 k4 = *(const LAS a4*)(kv + i); kk[i] = k4[0]; kk[i + 1] = k4[1]; kk[i + 2] = k4[2]; kk[i + 3] = k4[3]; }
#pragma unroll
                for (int i = 0; i < 32; ++i) ks += kk[i] * S[i];
                ks += __shfl_xor(ks, 1); ks += __shfl_xor(ks, 2);
                const float vn = beta * (vv - eg * ks);
                float os = 0.f;
#pragma unroll
                for (int i = 0; i < 32; i += 4) { const a4 q4 = *(const LAS a4*)(qv + i);
#pragma unroll
                    for (int e = 0; e < 4; ++e) { S[i + e] = eg * S[i + e] + kk[i + e] * vn; os += q4[e] * S[i + e]; } }
                os += __shfl_xor(os, 1); os += __shfl_xor(os, 2);
                if (rq == 0) ORAW[(row0 + t0 + r) * GDIM + h * 128 + c] = os;
            }
        }
#pragma unroll
        for (int i = 0; i < 32; ++i) sout[(size_t)(rq * 32 + i) * GD + c] = S[i];
    }
    __syncthreads();
}


namespace gdn {
typedef float f32x16 __attribute__((ext_vector_type(16)));
typedef short s16x4 __attribute__((ext_vector_type(4)));
typedef __attribute__((address_space(3))) const unsigned char* lptr;
constexpr int NCH = TP / 64;
constexpr int REC_W = 0, REC_Q = 16384, REC_K = 32768, REC_P = 49152, REC_BYTES = 57344;
constexpr int UT_FLOATS = 128 * 64;
constexpr int P_KB = 0, P_QB = 17408, P_SC = 34816, P_MM = 35840, P_PB = 53248, P_AB = 62464, P_RH = 71680, P_VB = 104448, P_END = 121856;
constexpr int S_W = 0, S_Q = 17408, S_K = 34816, S_P = 53248, S_U = 62464, S_EG = 71680, S_BUF = 71744;

__device__ __forceinline__ bf16x8 ld2x8(lptr p, int second) {
    const s16x4 a = *(const __attribute__((address_space(3))) s16x4*)p, b = *(const __attribute__((address_space(3))) s16x4*)(p + second);
    return (bf16x8){a[0], a[1], a[2], a[3], b[0], b[1], b[2], b[3]};
}
__device__ __forceinline__ unsigned long long pk4(float a, float b, float c, float d) { return (unsigned long long)pg8::cvt_pk_bf16(a, b) | ((unsigned long long)pg8::cvt_pk_bf16(c, d) << 32); }

__device__ __forceinline__ int kpos(int c) { const int x = c & 31; return (c & ~31) + 8 * ((x >> 2) & 3) + 4 * (x >> 4) + (x & 3); }
__device__ __forceinline__ void prep_unit(Frame& F, int unit) {
    const int tid = F.tid, lane = F.lane, wid = F.wave, r32 = lane & 31, hi = lane >> 5;
    const int bh = unit / NCH, n = unit % NCH, b = bh / GH, h = bh % GH;
    const size_t row0 = (size_t)b * TP + (size_t)n * 64;
    const float* QKVN = WSP(float, WS_QKVN); const float* GBETA = WSP(float, WS_GBETA);
    const float* qg = QKVN + row0 * CONVD + h * 128; const float* kg = qg + 512; const float* vg = qg + 1024;
    unsigned char* rec = WSP(unsigned char, WS_GREC) + (size_t)unit * REC_BYTES; bf16* UT = WSP(bf16, WS_GUT) + (size_t)unit * UT_FLOATS;
    LAS unsigned char* L = F.lds + RING_OFF;
    LAS float* SC = (LAS float*)(L + P_SC);
    LAS float* MM = (LAS float*)(L + P_MM);
    conv_rows8(F, row0 + 8 * wid, n * 64 + 8 * wid, b, h, lane, L, SC, 8 * wid);
    __syncthreads();
    if (wid == 0) {
        float cg = SC[lane];
#pragma unroll
        for (int o = 1; o < 64; o <<= 1) { const float t = __shfl_up(cg, o); if (lane >= o) cg += t; }
        const float cgl = __shfl(cg, 63);
        SC[lane] = cg; SC[128 + lane] = __expf(cg); SC[192 + lane] = __expf(cgl - cg);
        if (lane == 0) WSP(float, WS_GEG)[unit] = __expf(cgl);
    }
    __syncthreads();
    {
        const int rt = (wid >> 1) & 1, ct = wid & 1; const bool isq = wid >= 4;
        f32x16 acc;
#pragma unroll
        for (int r = 0; r < 16; ++r) acc[r] = 0.f;
        lptr ap = (lptr)(L + (isq ? P_QB : P_KB) + (32 * rt + r32) * 272 + hi * 16), bp = (lptr)(L + P_KB + (32 * ct + r32) * 272 + hi * 16);
#pragma unroll
        for (int s = 0; s < 8; ++s) acc = __builtin_amdgcn_mfma_f32_32x32x16_bf16(*(const __attribute__((address_space(3))) bf16x8*)(ap + s * 32), *(const __attribute__((address_space(3))) bf16x8*)(bp + s * 32), acc, 0, 0, 0);
        const int j = 32 * ct + r32; const float cgj = SC[j];
#pragma unroll
        for (int r = 0; r < 16; ++r) { const int i = 32 * rt + (r & 3) + 8 * (r >> 2) + 4 * hi;
            const float dec = __expf(fminf(SC[i] - cgj, 0.f));
            if (!isq) MM[i * 68 + j] = (i > j) ? SC[64 + i] * acc[r] * dec : 0.f;
            else *(LAS bf16*)(L + P_PB + i * 144 + kpos(j) * 2) = (bf16)(pg8::cvt_pk_bf16((i >= j) ? acc[r] * dec : 0.f, 0.f) & 0xffffu); }
    }
#pragma unroll
    for (int i = 0; i < 8; ++i) { const int f = tid + i * 512, c = f >> 6, col = (f & 63) * 4;
        const float sc = (col < 128) ? SC[64 + c] * SC[128 + c] : SC[64 + c];
        const unsigned long long x = *(const LAS unsigned long long*)(L + (col < 128 ? P_KB + c * 272 + col * 2 : P_VB + c * 272 + (col - 128) * 2));
        *(LAS unsigned long long*)(L + P_RH + (col >> 5) * 4096 + (c >> 3) * 512 + (c & 7) * 64 + (col & 31) * 2) =
            pk4(__uint_as_float((unsigned)x << 16) * sc, __uint_as_float((unsigned)x & 0xffff0000u) * sc, __uint_as_float((unsigned)(x >> 32) << 16) * sc, __uint_as_float((unsigned)(x >> 32) & 0xffff0000u) * sc); }
    __syncthreads();
    if (wid == 0) {
        float t[64];
#pragma unroll
        for (int i = 0; i < 64; ++i) {
            float a0 = (i == lane) ? 1.f : 0.f, a1 = 0.f, a2 = 0.f, a3 = 0.f;
#pragma unroll
            for (int j = 0; j < i; j += 4) { const a4 m = *(const LAS a4*)(MM + i * 68 + j);
                a0 -= m[0] * t[j]; if (j + 1 < i) a1 -= m[1] * t[j + 1]; if (j + 2 < i) a2 -= m[2] * t[j + 2]; if (j + 3 < i) a3 -= m[3] * t[j + 3]; }
            t[i] = (a0 + a1) + (a2 + a3);
            *(LAS bf16*)(L + P_AB + i * 144 + lane * 2) = (bf16)(pg8::cvt_pk_bf16(t[i], 0.f) & 0xffffu);
        }
    } else {
        const int t7 = tid - 64;
        for (int f = t7; f < 1024; f += 448) { const int row = f >> 4, c8 = (f & 15) * 8; const float e = SC[128 + row];
            a4 x0, x1; unpack8(*(const LAS v4u*)(L + P_QB + row * 272 + c8 * 2), x0, x1);
            *(unsigned long long*)(rec + REC_Q + row * 256 + kpos(c8) * 2) = pk4(x0[0] * e, x0[1] * e, x0[2] * e, x0[3] * e); *(unsigned long long*)(rec + REC_Q + row * 256 + kpos(c8 + 4) * 2) = pk4(x1[0] * e, x1[1] * e, x1[2] * e, x1[3] * e); }
        for (int f = t7; f < 1024; f += 448) { const int dk = f & 127, c8 = (f >> 7) * 8; float x[8];
#pragma unroll
            for (int e = 0; e < 8; ++e) x[e] = bf2f(*(const LAS bf16*)(L + P_KB + (c8 + e) * 272 + dk * 2)) * SC[192 + c8 + e];
            *(unsigned long long*)(rec + REC_K + dk * 128 + kpos(c8) * 2) = pk4(x[0], x[1], x[2], x[3]); *(unsigned long long*)(rec + REC_K + dk * 128 + kpos(c8 + 4) * 2) = pk4(x[4], x[5], x[6], x[7]); }
        for (int f = t7; f < 512; f += 448) { const int row = f >> 3, ch = f & 7; *(v4u*)(rec + REC_P + row * 128 + ch * 16) = *(const LAS v4u*)(L + P_PB + row * 144 + ch * 16); }
    }
    __syncthreads();
    {
        const int cb = wid;
        lptr vp = (lptr)(L + P_RH + cb * 4096) + ((lane >> 4) & 1) * 32 + (lane & 3) * 8 + (4 * hi + ((lane & 15) >> 2)) * 64;
        bf16x8 rf[4];
#pragma unroll
        for (int s = 0; s < 4; ++s) { const s16x4 lo = sba::vtr(vp + s * 1024), hh = sba::vtr(vp + s * 1024 + 512); rf[s] = (bf16x8){lo[0], lo[1], lo[2], lo[3], hh[0], hh[1], hh[2], hh[3]}; }
#pragma unroll
        for (int rt = 0; rt < 2; ++rt) {
            f32x16 acc;
#pragma unroll
            for (int r = 0; r < 16; ++r) acc[r] = 0.f;
            lptr ap = (lptr)(L + P_AB + (32 * rt + r32) * 144 + hi * 8);
#pragma unroll
            for (int s = 0; s < 4; ++s) { const bf16x8 af = ld2x8(ap + s * 32, 16);
                acc = (cb < 4) ? __builtin_amdgcn_mfma_f32_32x32x16_bf16(rf[s], af, acc, 0, 0, 0) : __builtin_amdgcn_mfma_f32_32x32x16_bf16(af, rf[s], acc, 0, 0, 0); }
            if (cb < 4) { const int c = 32 * rt + r32;
#pragma unroll
                for (int g = 0; g < 4; ++g) *(unsigned long long*)(rec + REC_W + c * 256 + kpos(32 * cb + 8 * g + 4 * hi) * 2) = pk4(acc[4 * g], acc[4 * g + 1], acc[4 * g + 2], acc[4 * g + 3]);
            } else { const int dv = 32 * (cb - 4) + r32;
#pragma unroll
                for (int g = 0; g < 4; ++g) *(unsigned long long*)(UT + dv * 64 + 32 * rt + 8 * g + 4 * hi) = pk4(acc[4 * g], acc[4 * g + 1], acc[4 * g + 2], acc[4 * g + 3]); }
        }
    }
    __syncthreads();
}

__device__ __forceinline__ void scan_task(Frame& F, int bh, int half) {
    const int tid = F.tid, lane = F.lane, wid = F.wave, col = lane & 15, q4 = lane >> 4, b = bh / GH, h = bh % GH, dv = 64 * half + 16 * (wid & 3) + col;
    const bool cw = wid < 4;
    const unsigned char* rec = WSP(unsigned char, WS_GREC) + (size_t)bh * NCH * REC_BYTES;
    const bf16* UT = WSP(bf16, WS_GUT) + (size_t)bh * NCH * UT_FLOATS + (size_t)64 * half * 64; const float* EG = WSP(float, WS_GEG) + bh * NCH;
    float* ORAW = WSP(float, WS_ORAW);
    LAS unsigned char* L = F.lds + RING_OFF;
    if (!cw) {
        const int lt = tid - 256;
        int ldso[16];
#pragma unroll
        for (int i = 0; i < 14; ++i) { const int p = lt + 256 * i;
            ldso[i] = p < 1024 ? S_W + (p >> 4) * 272 + (p & 15) * 16 : p < 2048 ? S_Q + ((p - 1024) >> 4) * 272 + (p & 15) * 16
                    : p < 3072 ? S_K + ((p - 2048) >> 3) * 144 + (p & 7) * 16 : S_P + ((p - 3072) >> 3) * 144 + (p & 7) * 16; }
#pragma unroll
        for (int i = 14; i < 16; ++i) { const int p = lt + 256 * (i - 14); ldso[i] = S_U + (p >> 3) * 144 + (p & 7) * 16; }
        v4u sa[16], sb[16]; float ea = 0.f, eb = 0.f;
#define SC_ISSUE(set, eg_, n_) do { _Pragma("unroll") for (int i = 0; i < 14; ++i) set[i] = *(const GAS v4u*)(rec + (size_t)(n_) * REC_BYTES + (size_t)(lt + 256 * i) * 16); \
        _Pragma("unroll") for (int i = 14; i < 16; ++i) set[i] = *(const GAS v4u*)((const unsigned char*)(UT + (size_t)(n_) * UT_FLOATS) + (size_t)(lt + 256 * (i - 14)) * 16); \
        eg_ = EG[n_]; } while (0)
#define SC_WRITE(set, eg_, buf) do { LAS unsigned char* Bw = L + (buf) * S_BUF; _Pragma("unroll") for (int i = 0; i < 16; ++i) *(LAS v4u*)(Bw + ldso[i]) = set[i]; \
        if (lt == 0) *(LAS float*)(Bw + S_EG) = eg_; } while (0)
        SC_ISSUE(sa, ea, 0); SC_ISSUE(sb, eb, 1);
        SC_WRITE(sa, ea, 0);
        __syncthreads();
        for (int n = 0; n < NCH; n += 2) {
            if (n + 2 < NCH) SC_ISSUE(sa, ea, n + 2);
            SC_WRITE(sb, eb, 1);
            __syncthreads();
            if (n + 3 < NCH) SC_ISSUE(sb, eb, n + 3);
            if (n + 2 < NCH) SC_WRITE(sa, ea, 0);
            __syncthreads();
        }
#undef SC_ISSUE
#undef SC_WRITE
        return;
    }
    a4 S[8];
#pragma unroll
    for (int t = 0; t < 8; ++t) S[t] = (a4){0.f, 0.f, 0.f, 0.f};
    __syncthreads();
    for (int n = 0; n < NCH; ++n) {
        LAS unsigned char* B = L + (n & 1) * S_BUF;
        unsigned long long u[4];
#pragma unroll
        for (int r = 0; r < 4; ++r) u[r] = *(const LAS unsigned long long*)(B + S_U + (16 * (wid & 3) + col) * 144 + (16 * r + 4 * q4) * 2);
        const float eg = *(const LAS float*)(B + S_EG);
        {
        bf16x8 Sb[4];
#pragma unroll
        for (int s = 0; s < 4; ++s) Sb[s] = sba::pack8f(S[2 * s][0], S[2 * s][1], S[2 * s][2], S[2 * s][3], S[2 * s + 1][0], S[2 * s + 1][1], S[2 * s + 1][2], S[2 * s + 1][3]);
        lptr wq = (lptr)(B + S_W + col * 272 + q4 * 16), qq = (lptr)(B + S_Q + col * 272 + q4 * 16), kq = (lptr)(B + S_K + col * 144 + q4 * 16), pq = (lptr)(B + S_P + col * 144 + q4 * 16);
#define GF(p) (*(const __attribute__((address_space(3))) bf16x8*)(p))
#define SBR() __builtin_amdgcn_sched_barrier(0)
#define UF(x) ((a4){__uint_as_float((unsigned)(x) << 16), __uint_as_float((unsigned)(x) & 0xffff0000u), __uint_as_float((unsigned)((x) >> 32) << 16), __uint_as_float((unsigned)((x) >> 32) & 0xffff0000u)})
        bf16x8 fa[8], fb[8];
        a4 vn[4], o[4];
#pragma unroll
        for (int i = 0; i < 8; ++i) fa[i] = GF(wq + (i >> 2) * 16 * 272 + (i & 3) * 64);
        SBR();
#pragma unroll
        for (int i = 0; i < 8; ++i) fb[i] = GF(wq + (2 + (i >> 2)) * 16 * 272 + (i & 3) * 64);
        SBR();
#pragma unroll
        for (int r = 0; r < 2; ++r) { a4 acc = {0.f, 0.f, 0.f, 0.f};
#pragma unroll
            for (int s = 0; s < 4; ++s) acc = __builtin_amdgcn_mfma_f32_16x16x32_bf16(fa[4 * r + s], Sb[s], acc, 0, 0, 0);
            vn[r] = UF(u[r]) - acc; }
        SBR();
#pragma unroll
        for (int i = 0; i < 8; ++i) fa[i] = GF(qq + (i >> 2) * 16 * 272 + (i & 3) * 64);
        SBR();
#pragma unroll
        for (int r = 0; r < 2; ++r) { a4 acc = {0.f, 0.f, 0.f, 0.f};
#pragma unroll
            for (int s = 0; s < 4; ++s) acc = __builtin_amdgcn_mfma_f32_16x16x32_bf16(fb[4 * r + s], Sb[s], acc, 0, 0, 0);
            vn[2 + r] = UF(u[2 + r]) - acc; }
        SBR();
#pragma unroll
        for (int i = 0; i < 8; ++i) fb[i] = GF(qq + (2 + (i >> 2)) * 16 * 272 + (i & 3) * 64);
        SBR();
#pragma unroll
        for (int r = 0; r < 2; ++r) { a4 acc = {0.f, 0.f, 0.f, 0.f};
#pragma unroll
            for (int s = 0; s < 4; ++s) acc = __builtin_amdgcn_mfma_f32_16x16x32_bf16(fa[4 * r + s], Sb[s], acc, 0, 0, 0);
            o[r] = acc; }
        bf16x8 vb[2];
#pragma unroll
        for (int s = 0; s < 2; ++s) vb[s] = sba::pack8f(vn[2 * s][0], vn[2 * s][1], vn[2 * s][2], vn[2 * s][3], vn[2 * s + 1][0], vn[2 * s + 1][1], vn[2 * s + 1][2], vn[2 * s + 1][3]);
        SBR();
#pragma unroll
        for (int i = 0; i < 8; ++i) fa[i] = GF(kq + (i >> 1) * 16 * 144 + (i & 1) * 64);
        SBR();
#pragma unroll
        for (int r = 0; r < 2; ++r) { a4 acc = {0.f, 0.f, 0.f, 0.f};
#pragma unroll
            for (int s = 0; s < 4; ++s) acc = __builtin_amdgcn_mfma_f32_16x16x32_bf16(fb[4 * r + s], Sb[s], acc, 0, 0, 0);
            o[2 + r] = acc; }
        SBR();
#pragma unroll
        for (int i = 0; i < 8; ++i) fb[i] = GF(kq + (4 + (i >> 1)) * 16 * 144 + (i & 1) * 64);
        SBR();
#pragma unroll
        for (int t = 0; t < 4; ++t) { a4 acc = S[t] * eg;
#pragma unroll
            for (int s = 0; s < 2; ++s) acc = __builtin_amdgcn_mfma_f32_16x16x32_bf16(fa[2 * t + s], vb[s], acc, 0, 0, 0);
            S[t] = acc; }
        SBR();
#pragma unroll
        for (int i = 0; i < 8; ++i) fa[i] = GF(pq + (i >> 1) * 16 * 144 + (i & 1) * 64);
        SBR();
#pragma unroll
        for (int t = 0; t < 4; ++t) { a4 acc = S[4 + t] * eg;
#pragma unroll
            for (int s = 0; s < 2; ++s) acc = __builtin_amdgcn_mfma_f32_16x16x32_bf16(fb[2 * t + s], vb[s], acc, 0, 0, 0);
            S[4 + t] = acc; }
        SBR();
#pragma unroll
        for (int r = 0; r < 4; ++r) {
#pragma unroll
            for (int s = 0; s < 2; ++s) o[r] = __builtin_amdgcn_mfma_f32_16x16x32_bf16(fa[2 * r + s], vb[s], o[r], 0, 0, 0);
        }
#undef GF
#undef SBR
#undef UF
        float* op = ORAW + ((size_t)b * TP + (size_t)n * 64 + 4 * q4) * GDIM + h * 128 + dv;
#pragma unroll
        for (int r = 0; r < 4; ++r)
#pragma unroll
            for (int e = 0; e < 4; ++e) op[(size_t)(16 * r + e) * GDIM] = o[r][e];
        }
        __syncthreads();
    }
    float* sout = F.out + O_SP + (size_t)bh * GD * GD + dv;
#pragma unroll
    for (int t = 0; t < 8; ++t)
#pragma unroll
        for (int e = 0; e < 4; ++e) sout[(size_t)(16 * t + 4 * q4 + e) * GD] = S[t][e];
}
}


__device__ __forceinline__ void p4_mixers(Frame& F, int qoff, unsigned long long& ts_a, unsigned long long& ts_b) {
    constexpr int NSC = NBP * GH, NPU = NBP * SBH * (TP / 256), NSU = NBS * sba::SNC;
    volatile LAS int* qs = (volatile LAS int*)(F.lds + LDSCTL_OFF + 64);
    if (F.vcu % 16 == 0 && F.vcu / 32 < NSC) gdn::scan_task(F, F.vcu / 32, (F.vcu >> 4) & 1);
    else if (F.vcu % 3 == 1) {
        for (;;) {
            __syncthreads();
            if (F.tid == 0) *qs = (int)__hip_atomic_fetch_add((unsigned*)(F.ctl + CW_Q3 + 64 + qoff), 1u, __ATOMIC_RELAXED, __HIP_MEMORY_SCOPE_AGENT);
            __syncthreads();
            const int u = __builtin_amdgcn_readfirstlane(*qs);
            if (u >= NSU) break;
            const int sq = u / sba::SNC, c = (sba::SNC - 1) - (u % sba::SNC), h = F.wave;
            sba::sample_wave_unit(F.lds + RING_OFF + F.wave * 8704, WSP(bf16, WS_QA), F.cache_k, F.cache_v, F.page_table, F.out, WSP(float, WS_SPO), WSP(float, WS_SPR), F.sb_bias[h] * LOG2E, sq, h, c, F.lane);
        }
    }
    if (PROBE_WAIT_PHASE >= 100 && PROBE_WAIT_PHASE < 200) ts_a = __builtin_amdgcn_s_memrealtime();
    for (;;) {
        __syncthreads();
        if (F.tid == 0) *qs = (int)__hip_atomic_fetch_add((unsigned*)(F.ctl + CW_Q3 + qoff), 1u, __ATOMIC_RELAXED, __HIP_MEMORY_SCOPE_AGENT);
        __syncthreads();
        const int u = __builtin_amdgcn_readfirstlane(*qs);
        if (u >= NPU + NBS * GH) break;
        if (u >= NPU) { gdn_naive_unit(F, NBP * GH + (u - NPU)); continue; }
        const int qb = (TP / 256 - 1) - u / (NBP * SBH), bh = u % (NBP * SBH), b = bh / SBH, h = bh % SBH;
        sba::prompt_unit(F.lds + RING_OFF, WSP(bf16, WS_QA), WSP(bf16, WS_KA), WSP(bf16, WS_VA), WSP(bf16, WS_OCAT), F.sb_bias[h] * LOG2E, b, h, qb, F.wave, F.lane);
    }
    if (PROBE_WAIT_PHASE >= 100 && PROBE_WAIT_PHASE < 200) ts_b = __builtin_amdgcn_s_memrealtime();
}
__device__ __forceinline__ void p5_sample_naive(Frame& F) {
    for (int un = F.vcu; un < NBS * GH; un += F.G) gdn_naive_unit(F, NBP * GH + un);
}
__device__ __forceinline__ void p3_gdn_prep(Frame& F, unsigned long long& ts0, unsigned long long& ts1, unsigned long long& ts2) {
    if (PROBE_WAIT_PHASE >= 300) ts0 = __builtin_amdgcn_s_memrealtime();
    int cnt = 0;
    for (int u = F.vcu; u < NBP * GH * gdn::NCH; u += F.G) { gdn::prep_unit(F, u); ++cnt;
        if (PROBE_WAIT_PHASE >= 300 && cnt == 1) ts1 = __builtin_amdgcn_s_memrealtime();
        if (PROBE_WAIT_PHASE >= 300 && cnt == 2) ts2 = __builtin_amdgcn_s_memrealtime(); }
    p2_gdn_prep(F); }
__device__ __forceinline__ void p5_gdn_post(Frame& F) {
    const int gw = F.vcu * NWAVES + F.wave, NGW = F.G * NWAVES, lane = F.lane;
    {
        const float* PO = WSP(float, WS_SPO); const float* PR = WSP(float, WS_SPR); bf16* Oc = WSP(bf16, WS_OCAT);
        for (int it = gw; it < NBS * SBH * TS; it += NGW) { const int j = it & 3, sh = it >> 2, sq = sh >> 3, h = sh & 7;
            float acc = 0.f, wgt = 1.f;
#pragma unroll
            for (int c = sba::SNC - 1; c >= 0; --c) { const size_t u = (size_t)sh * sba::SNC + c; acc += wgt * PO[u * 256 + j * 64 + lane]; wgt *= PR[u * 4 + j]; }
            Oc[((size_t)MP + 4 * sq + j) * DM + h * 64 + lane] = (bf16)(pg8::cvt_pk_bf16(acc, 0.f) & 0xffffu); }
    }
    const float* ORAW = WSP(float, WS_ORAW); const bf16* Zb = WSP(bf16, WS_ZB); bf16* Ocat = WSP(bf16, WS_OCAT);
    for (int it = gw; it < M * GH; it += NGW) {
        const int row = it >> 2, h = it & 3; const size_t ix = (size_t)row * GDIM + h * 128 + 2 * lane;
        const float o0 = ORAW[ix], o1 = ORAW[ix + 1];
        const float rs = __builtin_amdgcn_rsqf(wave_sum(o0 * o0 + o1 * o1) * (1.f / GD) + NORM_EPS);
        const unsigned zz = *(const unsigned*)(Zb + ix); const float z0 = __uint_as_float(zz << 16), z1 = __uint_as_float(zz & 0xffff0000u);
        const float r0 = o0 * rs * F.gdn_norm_w[2 * lane] * (z0 * sigmoidf_(z0)), r1 = o1 * rs * F.gdn_norm_w[2 * lane + 1] * (z1 * sigmoidf_(z1));
        *(unsigned*)(Ocat + (size_t)row * DM + 512 + h * 128 + 2 * lane) = pk2(r0, r1);
    }
}

__device__ __forceinline__ void p10_final(Frame& F) {
    const int gw = F.vcu * NWAVES + F.wave, NGW = F.G * NWAVES, lane = F.lane;
    f32x4 nw[4];
#pragma unroll
    for (int j = 0; j < 4; ++j) nw[j] = *((const f32x4*)F.norm_final_w + lane + 64 * j);
    for (int m = gw; m < M; m += NGW) {
        GAS f32x4* yr = (GAS f32x4*)(F.out + O_Y + (size_t)m * DM) + lane;
        f32x4 v[4]; float s = 0.f;
#pragma unroll
        for (int j = 0; j < 4; ++j) { v[j] = yr[64 * j]; s += (v[j].x * v[j].x + v[j].y * v[j].y) + (v[j].z * v[j].z + v[j].w * v[j].w); }
        const float rs = 1.f / sqrtf(wave_sum(s) * (1.f / DM) + NORM_EPS);
#pragma unroll
        for (int j = 0; j < 4; ++j) yr[64 * j] = v[j] * rs * nw[j];
    }
}

namespace sg {
typedef float f32x16 __attribute__((ext_vector_type(16)));
__device__ __forceinline__ void tile(LAS unsigned char* L, const bf16* A, size_t lda, const bf16* Bt, size_t ldb, int K, int wid, int lane, int tid, a4& s0, a4& s1) {
    const int r32 = lane & 31, hi = lane >> 5, nj = K / 128;
    f32x16 acc0, acc1;
#pragma unroll
    for (int r = 0; r < 16; ++r) { acc0[r] = 0.f; acc1[r] = 0.f; }
    const int kb = (wid >> 2) * (K / 2) + (wid & 3) * 16 + 8 * hi;
    const bf16* ap = A + (size_t)r32 * lda + kb; const bf16* b0p = Bt + (size_t)r32 * ldb + kb; const bf16* b1p = b0p + 32 * ldb;
    for (int s = 0; s < nj; s += 8) {
        bf16x8 af[8], bf0[8], bf1[8];
#pragma unroll
        for (int i = 0; i < 8; ++i) { af[i] = *(const bf16x8*)(ap + (s + i) * 64); bf0[i] = *(const bf16x8*)(b0p + (s + i) * 64); bf1[i] = *(const bf16x8*)(b1p + (s + i) * 64); }
        __builtin_amdgcn_sched_barrier(0);
#pragma unroll
        for (int i = 0; i < 8; ++i) { acc0 = __builtin_amdgcn_mfma_f32_32x32x16_bf16(af[i], bf0[i], acc0, 0, 0, 0); acc1 = __builtin_amdgcn_mfma_f32_32x32x16_bf16(af[i], bf1[i], acc1, 0, 0, 0); }
        __builtin_amdgcn_sched_barrier(0);
    }
    LAS float* P = (LAS float*)L + wid * (32 * 68);
#pragma unroll
    for (int r = 0; r < 16; ++r) { const int row = (r & 3) + 8 * (r >> 2) + 4 * hi; P[row * 68 + r32] = acc0[r]; P[row * 68 + 32 + r32] = acc1[r]; }
    __syncthreads();
    const LAS float* Q = (const LAS float*)L + (tid >> 4) * 68 + (tid & 15) * 4;
    s0 = *(const LAS a4*)Q + *(const LAS a4*)(Q + 32 * 68) + *(const LAS a4*)(Q + 2 * 32 * 68) + *(const LAS a4*)(Q + 3 * 32 * 68);
    s1 = *(const LAS a4*)(Q + 4 * 32 * 68) + *(const LAS a4*)(Q + 5 * 32 * 68) + *(const LAS a4*)(Q + 6 * 32 * 68) + *(const LAS a4*)(Q + 7 * 32 * 68);
    __syncthreads();
}

__device__ __forceinline__ void tile2(LAS unsigned char* L, const bf16* A, size_t lda, const bf16* Bt, size_t ldb, int K, int wid, int lane, int tid, a4& lo, a4& hi_) {
    const int r32 = lane & 31, hi = lane >> 5, nj = K / 64;
    f32x16 acc0, acc1;
#pragma unroll
    for (int r = 0; r < 16; ++r) { acc0[r] = 0.f; acc1[r] = 0.f; }
    const int kb = (wid & 3) * 16 + 8 * hi;
    const bf16* ap = A + (size_t)r32 * lda + kb; const bf16* b0p = Bt + (size_t)((wid >> 2) * 64 + r32) * ldb + kb; const bf16* b1p = b0p + 32 * ldb;
    for (int s = 0; s < nj; s += 8) {
        bf16x8 af[8], bf0[8], bf1[8];
#pragma unroll
        for (int i = 0; i < 8; ++i) { af[i] = *(const bf16x8*)(ap + (s + i) * 64); bf0[i] = *(const bf16x8*)(b0p + (s + i) * 64); bf1[i] = *(const bf16x8*)(b1p + (s + i) * 64); }
        __builtin_amdgcn_sched_barrier(0);
#pragma unroll
        for (int i = 0; i < 8; ++i) { acc0 = __builtin_amdgcn_mfma_f32_32x32x16_bf16(af[i], bf0[i], acc0, 0, 0, 0); acc1 = __builtin_amdgcn_mfma_f32_32x32x16_bf16(af[i], bf1[i], acc1, 0, 0, 0); }
        __builtin_amdgcn_sched_barrier(0);
    }
    LAS float* P = (LAS float*)L + wid * (32 * 68);
#pragma unroll
    for (int r = 0; r < 16; ++r) { const int row = (r & 3) + 8 * (r >> 2) + 4 * hi; P[row * 68 + r32] = acc0[r]; P[row * 68 + 32 + r32] = acc1[r]; }
    __syncthreads();
    const LAS float* Q = (const LAS float*)L + (tid >> 4) * 68 + (tid & 15) * 4;
    lo = *(const LAS a4*)Q + *(const LAS a4*)(Q + 32 * 68) + *(const LAS a4*)(Q + 2 * 32 * 68) + *(const LAS a4*)(Q + 3 * 32 * 68);
    hi_ = *(const LAS a4*)(Q + 4 * 32 * 68) + *(const LAS a4*)(Q + 5 * 32 * 68) + *(const LAS a4*)(Q + 6 * 32 * 68) + *(const LAS a4*)(Q + 7 * 32 * 68);
    __syncthreads();
}
}
__device__ __forceinline__ void sample_merge(Frame& F) {
    for (int t = blockIdx.x; t < (MS / 32) * (DM / 64); t += F.G) { const int r0 = (t >> 4) * 32, c0 = (t & 15) * 64; a4 s0, s1;
        sg::tile(F.lds + RING_OFF, WSP(bf16, WS_OCAT) + (size_t)(MP + r0) * DM, DM, WSP(bf16, WS_WCAT) + (size_t)c0 * DM, DM, DM, F.wave, F.lane, F.tid, s0, s1);
        const size_t idx = (size_t)(MP + r0 + (F.tid >> 4)) * DM + c0 + (F.tid & 15) * 4;
        const unsigned long long ga = *(const unsigned long long*)(WSP(bf16, WS_GA) + idx), gb = *(const unsigned long long*)(WSP(bf16, WS_GB) + idx);
        const a4 a = {__uint_as_float((unsigned)ga << 16), __uint_as_float((unsigned)ga & 0xffff0000u), __uint_as_float((unsigned)(ga >> 32) << 16), __uint_as_float((unsigned)(ga >> 32) & 0xffff0000u)};
        const a4 b = {__uint_as_float((unsigned)gb << 16), __uint_as_float((unsigned)gb & 0xffff0000u), __uint_as_float((unsigned)(gb >> 32) << 16), __uint_as_float((unsigned)(gb >> 32) & 0xffff0000u)};
        const a4 m = a * s0 + b * s1;
        *(unsigned long long*)(WSP(bf16, WS_MB) + idx) = gdn_pk4(m[0], m[1], m[2], m[3]); }
}
__device__ __forceinline__ void sample_wo(Frame& F) {
    for (int t = blockIdx.x; t < (MS / 32) * (DM / 64); t += F.G) { const int r0 = (t >> 4) * 32, c0 = (t & 15) * 64; a4 s0, s1;
        sg::tile(F.lds + RING_OFF, WSP(bf16, WS_MB) + (size_t)(MP + r0) * DM, DM, WSP(bf16, WS_WO) + (size_t)c0 * DM, DM, DM, F.wave, F.lane, F.tid, s0, s1);
        const int rs = r0 + (F.tid >> 4), col = c0 + (F.tid & 15) * 4; const size_t idx = (size_t)(MP + rs) * DM + col;
        const a4 x1 = *(const a4*)(F.xs + (size_t)rs * DM + col) + s0 + s1;
        *(a4*)(WSP(float, WS_X1) + idx) = x1; *(unsigned long long*)(WSP(bf16, WS_X1B) + idx) = gdn_pk4(x1[0], x1[1], x1[2], x1[3]);
        float ss = (x1[0] * x1[0] + x1[1] * x1[1]) + (x1[2] * x1[2] + x1[3] * x1[3]);
        ss += __shfl_xor(ss, 1); ss += __shfl_xor(ss, 2); ss += __shfl_xor(ss, 4); ss += __shfl_xor(ss, 8);
        if ((F.tid & 15) == 0) __hip_atomic_fetch_add((float*)(F.ctl + CW_SS1) + MP + rs, ss, __ATOMIC_RELAXED, __HIP_MEMORY_SCOPE_AGENT); }
}
__device__ __forceinline__ void sample_up(Frame& F) {
    for (int t = blockIdx.x; t < (MS / 32) * (FF / 128); t += F.G) { const int r0 = (t >> 5) * 32, c0 = (t & 31) * 128; a4 lo, hi;
        const int rs = r0 + (F.tid >> 4), col = c0 + (F.tid & 15) * 4;
        const float ssq = __hip_atomic_load((const float*)(F.ctl + CW_SS1) + MP + rs, __ATOMIC_RELAXED, __HIP_MEMORY_SCOPE_AGENT);
        sg::tile2(F.lds + RING_OFF, WSP(bf16, WS_X1B) + (size_t)(MP + r0) * DM, DM, WSP(bf16, WS_WUP) + (size_t)c0 * DM, DM, DM, F.wave, F.lane, F.tid, lo, hi);
        const float rstd = __builtin_amdgcn_rsqf(ssq * (1.f / DM) + NORM_EPS);
        lo = lo * rstd; hi = hi * rstd;
#pragma unroll
        for (int e = 0; e < 4; ++e) { const float a = fmaxf(lo[e], 0.f), b = fmaxf(hi[e], 0.f); lo[e] = a * a; hi[e] = b * b; }
        bf16* hp = WSP(bf16, WS_H) + (size_t)(MP + rs) * FF + col;
        *(unsigned long long*)hp = gdn_pk4(lo[0], lo[1], lo[2], lo[3]); *(unsigned long long*)(hp + 64) = gdn_pk4(hi[0], hi[1], hi[2], hi[3]); }
}
__device__ __forceinline__ void sample_down(Frame& F, bool fuse) {
    for (int t = blockIdx.x; t < (MS / 32) * (DM / 64); t += F.G) { const int r0 = (t >> 4) * 32, c0 = (t & 15) * 64; a4 s0, s1;
        sg::tile(F.lds + RING_OFF, WSP(bf16, WS_H) + (size_t)(MP + r0) * FF, FF, WSP(bf16, WS_WDN) + (size_t)c0 * FF, FF, FF, F.wave, F.lane, F.tid, s0, s1);
        const int rs = r0 + (F.tid >> 4), col = c0 + (F.tid & 15) * 4; const size_t idx = (size_t)(MP + rs) * DM + col;
        a4 x2 = *(const a4*)(WSP(float, WS_X1) + idx) + s0 + s1;
        if (fuse) {
            float* SS = (float*)(F.ctl + CW_SS2); gu32* cnt = F.ctl + CW_PC + 64 * (64 + (t >> 4));
            float ss = (x2[0] * x2[0] + x2[1] * x2[1]) + (x2[2] * x2[2] + x2[3] * x2[3]);
            ss += __shfl_xor(ss, 1); ss += __shfl_xor(ss, 2); ss += __shfl_xor(ss, 4); ss += __shfl_xor(ss, 8);
            if ((F.tid & 15) == 0) __hip_atomic_fetch_add(SS + MP + rs, ss, __ATOMIC_RELAXED, __HIP_MEMORY_SCOPE_AGENT);
            asm volatile("s_waitcnt vmcnt(0)" ::: "memory");
            __syncthreads();
            if (F.tid == 0) { __hip_atomic_fetch_add(cnt, 1u, __ATOMIC_RELAXED, __HIP_MEMORY_SCOPE_AGENT); wait_count(cnt, 16u); }
            __syncthreads();
            const float r = 1.f / sqrtf(__hip_atomic_load(SS + MP + rs, __ATOMIC_RELAXED, __HIP_MEMORY_SCOPE_AGENT) * (1.f / DM) + NORM_EPS);
            x2 = x2 * r * *(const a4*)(F.norm_final_w + col);
        }
        *(a4*)(F.out + O_Y + idx) = x2; }
}
constexpr int N_PHASES = 12;
struct Args { const void* in[21]; float* out; unsigned char* ws; int ph_lo, ph_hi; };
__global__ void __launch_bounds__(NTHR, 2) mk_fwd(Args args) {
    extern __shared__ __attribute__((aligned(16))) unsigned char lds[];
    Frame F;
    F.lds = (LAS unsigned char*)lds; F.MISC = (volatile LAS unsigned*)(F.lds + MISC_OFF);
    F.tid = threadIdx.x; F.lane = F.tid & 63; F.wave = __builtin_amdgcn_readfirstlane(F.tid >> 6);
    F.G = gridDim.x; { const int bx = blockIdx.x; F.vcu = (F.G % 8 == 0) ? (bx % 8) * (F.G / 8) + bx / 8 : bx; }
    F.ws = args.ws; F.out = args.out; F.ctl = (gu32*)(args.ws + WS_CTL);
    F.xp = (const float*)args.in[0]; F.xs = (const float*)args.in[1]; F.cache_k = (const float*)args.in[2]; F.cache_v = (const float*)args.in[3]; F.page_table = (const int*)args.in[4];
    F.state_conv = (const float*)args.in[5]; F.state_ssm = (const float*)args.in[6]; F.norm_mix_w = (const float*)args.in[7]; F.w_in = (const float*)args.in[8]; F.sb_bias = (const float*)args.in[9];
    F.conv_w = (const float*)args.in[10]; F.a_log = (const float*)args.in[11]; F.dt_bias = (const float*)args.in[12]; F.gdn_norm_w = (const float*)args.in[13]; F.w_pa = (const float*)args.in[14];
    F.w_pb = (const float*)args.in[15]; F.w_o = (const float*)args.in[16]; F.norm_mlp_w = (const float*)args.in[17]; F.w_up = (const float*)args.in[18]; F.w_down = (const float*)args.in[19];
    F.norm_final_w = (const float*)args.in[20];
    for (int u = F.tid; u < (LDS_BYTES - LDSCTL_OFF) / 4; u += NTHR) ((LAS unsigned*)(F.lds + LDSCTL_OFF))[u] = 0u;
    __syncthreads();
    const int lo = args.ph_lo, hi = args.ph_hi;
    XcdBarrier bar; bar.bar = (unsigned*)(F.ctl + CW_BAR); bar.x = 0; bar.st = nullptr;
    if (hi - lo > 1) bar = xcd_barrier_post((unsigned*)(F.ctl + CW_BAR), F.MISC + 8);
#define IN(k) (lo <= (k) && (k) < hi)
#define REPS(k) _Pragma("unroll") for (int rep = 0; rep < 1 + ((PROBE_REPEAT_MASK >> (k)) & 1); ++rep)
#define REPBAR() do { if (rep) xcd_barrier(bar); } while (0)
#define SEAM(k) do { if (IN(k) && IN((k) + 1) && (k) != 4 && (k) != 1) xcd_barrier(bar); } while (0)
    LAS unsigned char* ring = F.lds + RING_OFF;
    unsigned long long pw_t0 = 0, pw_t1 = 0, pw_ta = 0, pw_tb = 0, pw_t4 = 0;
#define PW0(k) do { if (PROBE_WAIT_PHASE == (k)) pw_t0 = __builtin_amdgcn_s_memrealtime(); } while (0)
#define PW1(k) do { if (PROBE_WAIT_PHASE == (k)) pw_t1 = __builtin_amdgcn_s_memrealtime(); } while (0)

    if (PROBE_WAIT_PHASE >= 200) pw_t4 = __builtin_amdgcn_s_memrealtime();
    PW0(0); if (IN(0)) REPS(0) { REPBAR(); p0_prologue(F, pw_ta); if (PROBE_WAIT_PHASE == 201) pw_tb = __builtin_amdgcn_s_memrealtime(); } SEAM(0); PW1(0);
    PW0(1); if (IN(1)) REPS(1) { REPBAR();
        pg8::Gemm g{WSP(bf16, WS_XN), WSP(bf16, WS_WIN), M, NIN, DM, DM}; StaticOrder S; S.init(M, NIN, F.G, (int)blockIdx.x);
        EpiIn E{WSP(bf16, WS_QA), WSP(bf16, WS_KA), WSP(bf16, WS_VA), WSP(bf16, WS_ZB), WSP(bf16, WS_GA), WSP(bf16, WS_GB), WSP(float, WS_U), F.out};
        pg8::gemm_phase<EpiIn, StaticOrder, true, true>(ring, g, S, E);
    } SEAM(1); PW1(1);
    do { if (IN(1) && IN(3)) xcd_barrier(bar); } while (0);
    PW0(3); if (IN(3)) REPS(3) { REPBAR(); p3_gdn_prep(F, pw_t4, pw_ta, pw_tb); } SEAM(3); PW1(3);
    if (PROBE_WAIT_PHASE >= 100 && PROBE_WAIT_PHASE < 200) pw_t4 = __builtin_amdgcn_s_memrealtime();
    PW0(4); if (IN(4)) REPS(4) { REPBAR(); p4_mixers(F, rep * 128, pw_ta, pw_tb); } SEAM(4);
    do { if (IN(4) && IN(6)) xcd_barrier(bar); } while (0); PW1(4);
    PW0(6); if (IN(6)) REPS(6) { REPBAR(); p5_gdn_post(F); } SEAM(6); PW1(6);
    PW0(7); if (IN(7)) REPS(7) { REPBAR();
        pg8::Gemm g{WSP(bf16, WS_OCAT), WSP(bf16, WS_WCAT), MP, DM, 512, DM}; MergeOrder S{F.G, (int)blockIdx.x, (MP / 256) * 4};
        EpiMerge E{WSP(bf16, WS_GA), WSP(bf16, WS_GB), WSP(bf16, WS_MB)};
        pg8::gemm_phase<EpiMerge, MergeOrder, false, true>(ring, g, S, E);
        sample_merge(F);
    } SEAM(7); PW1(7);
    PW0(8); if (IN(8)) REPS(8) { REPBAR();
        pg8::Gemm g{WSP(bf16, WS_MB), WSP(bf16, WS_WO), MP, DM, DM, DM}; StaticOrder S; S.init(MP, DM, F.G, (int)blockIdx.x);
        EpiRes E{F.xp, F.xs, WSP(float, WS_X1), WSP(bf16, WS_X1B), (float*)(F.ctl + (rep ? CW_SSD : CW_SS1))};
        pg8::gemm_phase<EpiRes, StaticOrder, false, true>(ring, g, S, E);
        if (!rep) sample_wo(F);
    } SEAM(8); PW1(8);
    PW0(9); if (IN(9)) REPS(9) { REPBAR();
        pg8::Gemm g{WSP(bf16, WS_X1B), WSP(bf16, WS_WUP), MP, FF, DM, DM}; StaticOrder S; S.init(MP, FF, F.G, (int)blockIdx.x);
        EpiUp E{(const float*)(F.ctl + CW_SS1), WSP(bf16, WS_H)};
        pg8::gemm_phase<EpiUp, StaticOrder, true, true>(ring, g, S, E);
        sample_up(F);
    } SEAM(9); PW1(9);
    const bool fuse_final = (F.G == 256) && (PROBE_REPEAT_MASK == 0);
    PW0(10); if (IN(10)) REPS(10) { REPBAR();
        pg8::Gemm g{WSP(bf16, WS_H), WSP(bf16, WS_WDN), MP, DM, FF, FF}; StaticOrder S; S.init(MP, DM, F.G, (int)blockIdx.x);
        if (fuse_final) { EpiDownF E{WSP(float, WS_X1), F.out + O_Y, (float*)(F.ctl + CW_SS2), F.ctl + CW_PC, F.norm_final_w};
            pg8::gemm_phase<EpiDownF, StaticOrder, false, true>(ring, g, S, E); }
        else { EpiDown E{WSP(float, WS_X1), F.out + O_Y};
            pg8::gemm_phase<EpiDown, StaticOrder, false, true>(ring, g, S, E); }
        sample_down(F, fuse_final);
    } if (!fuse_final) SEAM(10); PW1(10);
    PW0(11); if (IN(11) && !fuse_final) { p10_final(F); } PW1(11);
    if (PROBE_WAIT_PHASE >= 300) { pw_t0 = PROBE_WAIT_PHASE == 300 ? pw_t4 : pw_ta; pw_t1 = PROBE_WAIT_PHASE == 300 ? pw_ta : pw_tb;
        if (blockIdx.x == 0) { const unsigned long long tw = __builtin_amdgcn_s_memrealtime(); while (__builtin_amdgcn_s_memrealtime() - tw < pw_t1 - pw_t0) __builtin_amdgcn_s_sleep(8); } }
    else if (PROBE_WAIT_PHASE >= 200) { pw_t0 = PROBE_WAIT_PHASE == 200 ? pw_t4 : pw_ta; pw_t1 = PROBE_WAIT_PHASE == 200 ? pw_ta : pw_tb;
        if (blockIdx.x == 0) { const unsigned long long tw = __builtin_amdgcn_s_memrealtime(); while (__builtin_amdgcn_s_memrealtime() - tw < pw_t1 - pw_t0) __builtin_amdgcn_s_sleep(8); } }
    else if (PROBE_WAIT_PHASE >= 100) { const int wb = PROBE_WAIT_PHASE == 100 ? 0 : PROBE_WAIT_PHASE == 102 ? 16 : 8; pw_t0 = pw_t4; pw_t1 = (PROBE_WAIT_PHASE == 102 || PROBE_WAIT_PHASE == 103) ? pw_tb : pw_ta;
        if ((int)blockIdx.x == wb) { const unsigned long long tw = __builtin_amdgcn_s_memrealtime(); while (__builtin_amdgcn_s_memrealtime() - tw < pw_t1 - pw_t0) __builtin_amdgcn_s_sleep(8); } }
    else if (PROBE_WAIT_PHASE >= 0 && blockIdx.x == 0) { const unsigned long long tw = __builtin_amdgcn_s_memrealtime(); while (__builtin_amdgcn_s_memrealtime() - tw < pw_t1 - pw_t0) __builtin_amdgcn_s_sleep(8); }
#undef IN
#undef SEAM
}

extern "C" void kernel_launch(void* const* d_in, const int* in_sizes, int n_in, void* d_out, int out_size, void* d_ws, size_t ws_size, hipStream_t stream) {
    static int grid = 0;
    if (grid == 0) {
        if (n_in != 21 || out_size != (int)O_END || ws_size < WS_END) { fprintf(stderr, "kernel_launch: unexpected shapes (n_in %d, out %d, ws %zu); nothing launched\n", n_in, out_size, ws_size); grid = -1; return; }
        int dev = 0, cus = 0, per_cu = 0;
        if (hipGetDevice(&dev) != hipSuccess || hipDeviceGetAttribute(&cus, hipDeviceAttributeMultiprocessorCount, dev) != hipSuccess) { grid = -1; return; }
        if (hipFuncSetAttribute((const void*)mk_fwd, hipFuncAttributeMaxDynamicSharedMemorySize, LDS_BYTES) != hipSuccess) { fprintf(stderr, "kernel_launch: hipFuncSetAttribute failed\n"); grid = -1; return; }
        if (hipOccupancyMaxActiveBlocksPerMultiprocessor(&per_cu, (const void*)mk_fwd, NTHR, LDS_BYTES) != hipSuccess || per_cu < 1) { fprintf(stderr, "kernel_launch: occupancy query says %d\n", per_cu); }
        (void)hipGetLastError();
        grid = cus;
    }
    if (grid < 0) return;
    if (hipMemsetAsync((char*)d_ws + WS_CTL, 0, CTL_ZERO_BYTES, stream) != hipSuccess) return;
    Args a{};
    for (int i = 0; i < 21; ++i) a.in[i] = d_in[i];
    a.out = (float*)d_out; a.ws = (unsigned char*)d_ws;
    if (MK_N_LAUNCHES == 1) { a.ph_lo = 0; a.ph_hi = N_PHASES; hipLaunchKernelGGL(mk_fwd, dim3(grid), dim3(NTHR), LDS_BYTES, stream, a); }
    else for (int p = 0; p < N_PHASES; ++p) { a.ph_lo = p; a.ph_hi = p + 1; hipLaunchKernelGGL(mk_fwd, dim3(grid), dim3(NTHR), LDS_BYTES, stream, a); }
}
```

```cpp
#include <hip/hip_runtime.h>
#include <cstdio>
#include <cstdint>

#ifndef PROBE_REPEAT_MASK
#define PROBE_REPEAT_MASK 0
#endif
#ifndef PROBE_WAIT_PHASE
#define PROBE_WAIT_PHASE -1
#endif
#ifndef MK_N_LAUNCHES
#define MK_N_LAUNCHES 1
#endif

namespace pg8 {
#define PG8_LAS __attribute__((address_space(3)))
typedef unsigned short bf16_t;
typedef short bf16x8 __attribute__((ext_vector_type(8)));
typedef float f32x4 __attribute__((ext_vector_type(4)));
typedef unsigned u32x4 __attribute__((ext_vector_type(4)));
constexpr int BM = 256, BK = 64, HALF = 128, HTB = HALF * BK * 2  , STAGE_BYTES = 8 * HTB, NXCD = 8, WGM = 8;

__host__ __device__ __forceinline__ int lds_byte(int r, int c) { const int st = (r >> 4) * 2 + (c >> 5), rr = r & 15, cc = c & 31, ob = rr * 64 + cc * 2; return st * 1024 + (ob ^ (((ob >> 9) & 1) << 5)); }
__host__ __device__ __forceinline__ void stage_rc(int b, int& R, int& C) { const int st = b / 1024, sb = b % 1024, swz = sb ^ (((sb >> 9) & 1) << 5); R = (st >> 1) * 16 + swz / 64; C = (st & 1) * 32 + (swz % 64) / 2; }
__host__ __device__ __forceinline__ int perm32(int rho) { const int n = rho >> 4, i = rho & 15; return 8 * (i >> 2) + 4 * n + (i & 3); }

struct Unit { int pm, pn, ko, nk; };
struct Gemm { const bf16_t* A; const bf16_t* Bt; int M, N, K, ld; };
typedef float f32x2_t __attribute__((ext_vector_type(2))); typedef __bf16 bf16x2_t __attribute__((ext_vector_type(2)));
__device__ __forceinline__ unsigned cvt_pk_bf16(float lo, float hi) { f32x2_t v = {lo, hi}; bf16x2_t b = __builtin_convertvector(v, bf16x2_t); return __builtin_bit_cast(unsigned, b); }


template <class Epi, class Sched, bool ALIGN_EPI = false, bool SP2 = false>
__device__ __forceinline__ void gemm_phase(PG8_LAS unsigned char* lds, const Gemm g, const Sched& S, const Epi& E) {
    const int tid = threadIdx.x, wid = __builtin_amdgcn_readfirstlane(tid >> 6), lane = tid & 63, wr = wid >> 2, wc = wid & 3, fr = lane & 15, fq = lane >> 4;
    const int K = g.ld, nt0 = g.K / BK;
    unsigned voffA[2], voffB[2];
#pragma unroll
    for (int i = 0; i < 2; ++i) { int R, C; stage_rc(tid * 16 + i * 8192, R, C); const int Rb = Epi::PERM ? ((R & ~31) + perm32(R & 31)) : R;
        voffA[i] = (unsigned)(R * K + C) * 2u; voffB[i] = (unsigned)(Rb * K + C) * 2u; }
    const size_t kstep = (size_t)(BK * 2);
    const size_t hstep = (size_t)HALF * K * 2;
    const size_t tstep = 2 * hstep;
    const unsigned ldsw = (unsigned)wid * 1024u;
    const int aoff = lds_byte(wr * 64 + fr, fq * 8), boff = lds_byte(wc * 32 + fr, fq * 8);
#define PG8_SA(b, h) (((b) * 2 + (h)) * HTB)
#define PG8_SB(b, h) ((4 + (b) * 2 + (h)) * HTB)
#define PG8_STAGE(bufoff, gbase, voff) do { _Pragma("unroll") for (int _i = 0; _i < 2; ++_i) \
        __builtin_amdgcn_global_load_lds((const unsigned*)((const char*)(gbase) + (voff)[_i]), (PG8_LAS unsigned*)(lds + (bufoff) + ldsw + _i * 8192), 16, 0, 0); } while (0)
#define PG8_LDA(dst, b, h) do { _Pragma("unroll") for (int m = 0; m < 4; ++m) _Pragma("unroll") for (int k = 0; k < 2; ++k) dst[m][k] = *(const PG8_LAS bf16x8*)(lds + PG8_SA(b, h) + aoff + m * 2048 + k * 1024); } while (0)
#define PG8_LDB(dst, b, h) do { _Pragma("unroll") for (int n = 0; n < 2; ++n) _Pragma("unroll") for (int k = 0; k < 2; ++k) dst[n][k] = *(const PG8_LAS bf16x8*)(lds + PG8_SB(b, h) + boff + n * 2048 + k * 1024); } while (0)
#define PG8_MMA(ai, bj, At, Bt) do { __builtin_amdgcn_s_setprio(1); _Pragma("unroll") for (int m = 0; m < 4; ++m) _Pragma("unroll") for (int n = 0; n < 2; ++n) _Pragma("unroll") for (int k = 0; k < 2; ++k) \
        acc[ai][bj][m][n] = __builtin_amdgcn_mfma_f32_16x16x32_bf16(Bt[n][k], At[m][k], acc[ai][bj][m][n], 0, 0, 0); __builtin_amdgcn_s_setprio(0); } while (0)
#define PG8_WAIT_V(n) asm volatile("s_waitcnt vmcnt(" #n ")" ::: "memory")
#define PG8_WAIT_L(n) asm volatile("s_waitcnt lgkmcnt(" #n ")" ::: "memory")
#define PG8_BAR __builtin_amdgcn_s_barrier()
#define PG8_SCHED __builtin_amdgcn_sched_barrier(0)
    Unit cur, nxt; int ui = 0;
    if (!S.next(0, cur)) return;
    f32x4 acc[2][2][4][2];
#pragma unroll
    for (int a = 0; a < 2; ++a)
#pragma unroll
        for (int b = 0; b < 2; ++b)
#pragma unroll
            for (int m = 0; m < 4; ++m)
#pragma unroll
                for (int n = 0; n < 2; ++n) acc[a][b][m][n] = (f32x4){0.f, 0.f, 0.f, 0.f};
    bf16x8 At[4][2], B0[2][2], B1[2][2];
    const char* cA = (const char*)g.A + (size_t)cur.pm * tstep + (size_t)cur.ko * 2; const char* cB = (const char*)g.Bt + (size_t)cur.pn * tstep + (size_t)cur.ko * 2;
    S.a_ready(cur);
    if constexpr (SP2) {
        PG8_STAGE(PG8_SB(0, 0), cB, voffB); PG8_STAGE(PG8_SB(0, 1), cB + hstep, voffB); PG8_STAGE(PG8_SA(0, 0), cA, voffA); PG8_STAGE(PG8_SA(0, 1), cA + hstep, voffA);
        if (wr == 1) PG8_BAR;
        PG8_WAIT_V(2); PG8_BAR;
        PG8_STAGE(PG8_SB(1, 0), cB + kstep, voffB); PG8_STAGE(PG8_SA(1, 0), cA + kstep, voffA); PG8_STAGE(PG8_SB(1, 1), cB + hstep + kstep, voffB);
        PG8_WAIT_V(6); PG8_BAR;
    } else {
        PG8_STAGE(PG8_SB(0, 0), cB, voffB); PG8_STAGE(PG8_SA(0, 0), cA, voffA); PG8_STAGE(PG8_SB(0, 1), cB + hstep, voffB); PG8_STAGE(PG8_SA(0, 1), cA + hstep, voffA);
        if (wr == 1) PG8_BAR;
        PG8_WAIT_V(4); PG8_BAR;
        PG8_STAGE(PG8_SB(1, 0), cB + kstep, voffB); PG8_STAGE(PG8_SA(1, 0), cA + kstep, voffA); PG8_STAGE(PG8_SB(1, 1), cB + hstep + kstep, voffB);
        PG8_WAIT_V(6); PG8_BAR;
    }
    for (;;) {
        const bool has_next = S.next(ui + 1, nxt);
        const char* nA = has_next ? (const char*)g.A + (size_t)nxt.pm * tstep + (size_t)nxt.ko * 2 : cA; const char* nB = has_next ? (const char*)g.Bt + (size_t)nxt.pn * tstep + (size_t)nxt.ko * 2 : cB;
        const int nt = cur.nk ? cur.nk : nt0;
        for (int t = 0; t < nt; t += 2) {
            const bool last = (t == nt - 2);
            const char* a1 = cA + (size_t)(t + 1) * kstep;
            const char* a2 = last ? nA : cA + (size_t)(t + 2) * kstep; const char* b2 = last ? nB : cB + (size_t)(t + 2) * kstep;
            const char* a3 = a2 + kstep; const char* b3 = b2 + kstep;
            if (last && has_next) S.a_ready(nxt);
            if constexpr (SP2) {
            PG8_LDB(B0, 0, 0); PG8_LDB(B1, 0, 1); PG8_SCHED; PG8_LDA(At, 0, 0); PG8_STAGE(PG8_SA(1, 1), a1 + hstep, voffA);
            PG8_WAIT_V(8); PG8_WAIT_L(0); PG8_BAR; PG8_MMA(0, 0, At, B0); PG8_MMA(0, 1, At, B1); PG8_BAR; PG8_SCHED;
            PG8_LDA(At, 0, 1); PG8_STAGE(PG8_SB(0, 0), b2, voffB); PG8_STAGE(PG8_SB(0, 1), b2 + hstep, voffB); PG8_STAGE(PG8_SA(0, 0), a2, voffA);
            PG8_WAIT_V(8); PG8_WAIT_L(0); PG8_BAR; PG8_MMA(1, 0, At, B0); PG8_MMA(1, 1, At, B1); PG8_BAR; PG8_SCHED;
            PG8_LDB(B0, 1, 0); PG8_LDB(B1, 1, 1); PG8_SCHED; PG8_LDA(At, 1, 0); PG8_STAGE(PG8_SA(0, 1), a2 + hstep, voffA);
            PG8_WAIT_V(8); PG8_WAIT_L(0); PG8_BAR; PG8_MMA(0, 0, At, B0); PG8_MMA(0, 1, At, B1); PG8_BAR; PG8_SCHED;
            PG8_LDA(At, 1, 1); PG8_STAGE(PG8_SB(1, 0), b3, voffB); PG8_STAGE(PG8_SB(1, 1), b3 + hstep, voffB); PG8_STAGE(PG8_SA(1, 0), a3, voffA);
            PG8_WAIT_V(8); PG8_WAIT_L(0); PG8_BAR; PG8_MMA(1, 0, At, B0); PG8_MMA(1, 1, At, B1); PG8_BAR; PG8_SCHED;
            } else {
            PG8_LDB(B0, 0, 0); PG8_SCHED; PG8_LDA(At, 0, 0); PG8_STAGE(PG8_SA(1, 1), a1 + hstep, voffA);
            PG8_WAIT_L(8); PG8_BAR; PG8_WAIT_L(0); PG8_MMA(0, 0, At, B0); PG8_BAR; PG8_SCHED;
            PG8_LDB(B1, 0, 1); PG8_STAGE(PG8_SB(0, 0), b2, voffB);
            PG8_BAR; PG8_WAIT_L(0); PG8_MMA(0, 1, At, B1); PG8_BAR;
            PG8_LDA(At, 0, 1); PG8_STAGE(PG8_SA(0, 0), a2, voffA);
            PG8_BAR; PG8_WAIT_L(0); PG8_MMA(1, 0, At, B0); PG8_BAR; PG8_SCHED;
            PG8_STAGE(PG8_SB(0, 1), b2 + hstep, voffB);
            PG8_WAIT_V(6); PG8_BAR; PG8_MMA(1, 1, At, B1); PG8_BAR;
            PG8_LDB(B0, 1, 0); PG8_SCHED; PG8_LDA(At, 1, 0); PG8_STAGE(PG8_SA(0, 1), a2 + hstep, voffA);
            PG8_WAIT_L(8); PG8_BAR; PG8_WAIT_L(0); PG8_MMA(0, 0, At, B0); PG8_BAR; PG8_SCHED;
            PG8_LDB(B1, 1, 1); PG8_STAGE(PG8_SB(1, 0), b3, voffB);
            PG8_BAR; PG8_WAIT_L(0); PG8_MMA(0, 1, At, B1); PG8_BAR;
            PG8_LDA(At, 1, 1); PG8_STAGE(PG8_SA(1, 0), a3, voffA);
            PG8_BAR; PG8_WAIT_L(0); PG8_MMA(1, 0, At, B0); PG8_BAR; PG8_SCHED;
            PG8_STAGE(PG8_SB(1, 1), b3 + hstep, voffB);
            PG8_WAIT_V(6); PG8_BAR; PG8_MMA(1, 1, At, B1); PG8_BAR;
            }
        }
        if constexpr (ALIGN_EPI) { if (wr == 0) PG8_BAR; }
        if constexpr (!Epi::AFTER_DRAIN) { E(acc, cur, wr, wc, fr, fq); S.done(cur); }
        if (!has_next) break;
        if (!(Epi::MIDK > 0 && cur.ko == 0)) {
#pragma unroll
        for (int a = 0; a < 2; ++a)
#pragma unroll
            for (int b = 0; b < 2; ++b)
#pragma unroll
                for (int m = 0; m < 4; ++m)
#pragma unroll
                    for (int n = 0; n < 2; ++n) acc[a][b][m][n] = (f32x4){0.f, 0.f, 0.f, 0.f};
        }
        cur = nxt; cA = nA; cB = nB; ++ui;
        if constexpr (ALIGN_EPI) { if (wr == 1) PG8_BAR; }
    }
    PG8_WAIT_V(0);
    if constexpr (!ALIGN_EPI) { if (wr == 0) PG8_BAR; }
    PG8_BAR;
    if constexpr (Epi::AFTER_DRAIN) { E.fused(acc, cur, wr, wc, fr, fq, lds, wid, lane); S.done(cur); }
#undef PG8_SA
#undef PG8_SB
#undef PG8_STAGE
#undef PG8_LDA
#undef PG8_LDB
#undef PG8_MMA
#undef PG8_WAIT_V
#undef PG8_WAIT_L
#undef PG8_BAR
#undef PG8_SCHED
}
}


#define GAS __attribute__((address_space(1)))
#define LAS __attribute__((address_space(3)))
typedef unsigned short bf16;
typedef unsigned v4u __attribute__((ext_vector_type(4)));
typedef float f32x4 __attribute__((ext_vector_type(4)));
typedef short bf16x8 __attribute__((ext_vector_type(8)));
typedef GAS unsigned gu32;
typedef GAS unsigned long long gu64;
#define RLX_AGENT __ATOMIC_RELAXED, __HIP_MEMORY_SCOPE_AGENT
#define LDS_WAIT() asm volatile("s_waitcnt lgkmcnt(0)" ::: "memory")
#define VM_WAIT() asm volatile("s_waitcnt vmcnt(0)" ::: "memory")
__device__ __forceinline__ unsigned long long rt() { return __builtin_amdgcn_s_memrealtime(); }
__device__ __forceinline__ unsigned f2bf(float f) { unsigned u = __builtin_bit_cast(unsigned, f); return (u + 0x7fffu + ((u >> 16) & 1u)) >> 16; }
__device__ __forceinline__ unsigned pk2(float lo, float hi) { return f2bf(lo) | (f2bf(hi) << 16); }

#define XB_TMO      128
#define XB_XCNT(j)  (256  + 64 * (j))
#define XB_XSUB(j)  (1280 + 64 * (j))
#define XB_XGEN(j)  (2304 + 64 * (j))
#define XB_TOP      3328
#define XB_TOPGEN   3392
#define XCD_BAR_WORDS 3456
#define XB_SPIN_CAP (1u << 18)

__device__ __forceinline__ unsigned xb_ld(unsigned* p)              { return __hip_atomic_load(p, __ATOMIC_RELAXED, __HIP_MEMORY_SCOPE_AGENT); }
__device__ __forceinline__ unsigned xb_add(unsigned* p, unsigned v) { return __hip_atomic_fetch_add(p, v, __ATOMIC_RELAXED, __HIP_MEMORY_SCOPE_AGENT); }
__device__ __forceinline__ unsigned xb_xcc_id() { return (unsigned)__builtin_amdgcn_s_getreg((3 << 11) | 20) & 0xFu; }
#define XB_SPIN(cond, bar) do { unsigned _sp = 0; while (cond) { __builtin_amdgcn_s_sleep(1); \
    if ((++_sp & 255u) == 0u) { if (xb_ld(&(bar)[XB_TMO])) break; if (_sp > XB_SPIN_CAP) { atomicAdd(&(bar)[XB_TMO], 1u); break; } } } } while (0)

struct XcdBarrier {
    unsigned* bar; unsigned x;
    volatile LAS unsigned* st;
};

__device__ __forceinline__ XcdBarrier xcd_barrier_post(unsigned* bar, volatile LAS unsigned* st) {
    XcdBarrier b; b.bar = bar; b.x = xb_xcc_id(); b.st = st;
    if (threadIdx.x == 0) (void)xb_add(&bar[XB_XCNT(b.x)], 1u);
    return b;
}
__device__ __forceinline__ void xcd_barrier_complete(unsigned* bar, unsigned x, unsigned& nloc, unsigned& nx) {
    const unsigned G = gridDim.x * gridDim.y * gridDim.z;
    unsigned sum, cnt, mine, sp = 0u;
    for (;;) {
        sum = 0u; cnt = 0u; mine = 0u;
#pragma unroll
        for (unsigned j = 0; j < 16; ++j) { const unsigned c = xb_ld(&bar[XB_XCNT(j)]); sum += c; cnt += (c > 0u) ? 1u : 0u; mine = (j == x) ? c : mine; }
        if (sum == G) break;
        __builtin_amdgcn_s_sleep(1);
        if ((++sp & 255u) == 0u) { if (xb_ld(&bar[XB_TMO])) break; if (sp > XB_SPIN_CAP) { atomicAdd(&bar[XB_TMO], 1u); break; } }
    }
    nloc = mine > 0u ? mine : 1u; nx = cnt > 0u ? cnt : 1u;
}

__device__ __forceinline__ void xcd_barrier(const XcdBarrier& b) {
    asm volatile("s_waitcnt vmcnt(0)" ::: "memory");
    __syncthreads();
    if (threadIdx.x == 0) {
        unsigned* bar = b.bar;
        __builtin_amdgcn_s_waitcnt(0);
        unsigned nloc = b.st[0], nx = b.st[1];
        if (nloc == 0u) { xcd_barrier_complete(bar, b.x, nloc, nx); b.st[0] = nloc; b.st[1] = nx; }
        const unsigned old = xb_add(&bar[XB_XSUB(b.x)], 1u);
        const unsigned gen = old / nloc;
        if (old + 1u == (gen + 1u) * nloc) {
            __builtin_amdgcn_fence(__ATOMIC_RELEASE, "agent");
            asm volatile("s_waitcnt vmcnt(0)" ::: "memory");
            const unsigned og = xb_add(&bar[XB_TOP], 1u);
            const unsigned tg = og / nx;
            if (og + 1u == (tg + 1u) * nx) xb_add(&bar[XB_TOPGEN], 1u);
            else XB_SPIN(xb_ld(&bar[XB_TOPGEN]) == tg, bar);
            __builtin_amdgcn_fence(__ATOMIC_ACQUIRE, "agent");
            xb_add(&bar[XB_XGEN(b.x)], 1u);
            asm volatile("s_waitcnt vmcnt(0)" ::: "memory");
        } else {
            XB_SPIN(xb_ld(&bar[XB_XGEN(b.x)]) == gen, bar);
            __builtin_amdgcn_fence(__ATOMIC_ACQUIRE, "agent");
            asm volatile("s_waitcnt vmcnt(0)" ::: "memory");
        }
    }
    __syncthreads();
}


constexpr int DM = 1024, TP = 8192, NBP = 2, MP = NBP * TP, NBS = 128, TS = 4, MS = NBS * TS, M = MP + MS;
constexpr int SBH = 8, SBD = 64, SBDIM = 512, GH = 4, GD = 128, GDIM = 512, CONVD = 1536, FF = 4096;
constexpr int PAST = 2048, PAGE = 128, NPAGES = 16;
constexpr int INW = 5640, NIN = 5632;
constexpr float NORM_EPS = 1e-6f, L2_EPS = 1e-6f, LOG2E = 1.4426950408889634f, QSCALE = 0.125f * 1.4426950408889634f;
constexpr int NWAVES = 8, NTHR = 512;

constexpr size_t O_Y = 0, O_KP = (size_t)M * DM, O_VP = O_KP + (size_t)MP * 512, O_KS = O_VP + (size_t)MP * 512, O_VS = O_KS + (size_t)MS * 512,
    O_CP = O_VS + (size_t)MS * 512, O_CS = O_CP + (size_t)NBP * 3 * CONVD, O_SP = O_CS + (size_t)NBS * 3 * CONVD, O_SS = O_SP + (size_t)NBP * GH * GD * GD,
    O_END = O_SS + (size_t)NBS * GH * GD * GD;
static_assert(O_END == 43721728, "output size");

constexpr size_t MiB = 1u << 20;
constexpr size_t WS_CTL = 0, CTL_ZERO_BYTES = 1 * MiB;
constexpr size_t WS_WIN = 2 * MiB, WS_WCAT = 14 * MiB, WS_WO = 16 * MiB, WS_WUP = 18 * MiB, WS_WDN = 26 * MiB;
constexpr size_t WS_AB = 34 * MiB, WS_GBETA = 35 * MiB, WS_XN = 36 * MiB, WS_QA = 69 * MiB, WS_KA = 86 * MiB, WS_VA = 103 * MiB, WS_U = 120 * MiB;
constexpr size_t WS_ZB = 219 * MiB, WS_GA = 236 * MiB, WS_GB = 269 * MiB, WS_OCAT = 302 * MiB, WS_TMP = 335 * MiB, WS_MB = 401 * MiB, WS_X1 = 434 * MiB, WS_X1B = 500 * MiB;
constexpr size_t WS_H = 533 * MiB, WS_QKVN = 665 * MiB, WS_ORAW = 764 * MiB, WS_GREC = 800 * MiB, WS_GUT = 856 * MiB, WS_GEG = 888 * MiB, WS_SPO = 889 * MiB, WS_SPR = 894 * MiB, WS_SLAB = 895 * MiB, WS_END = 927 * MiB;
constexpr int CW_TMO = 0, CW_CODE = 1, CW_BAR = 4096, CW_SS1 = 65536, CW_SS2 = 98304, CW_SSD = 131072, CW_PC = 150016;
static_assert((CW_SSD + M) * 4 <= (int)CTL_ZERO_BYTES, "control words inside the memset region");

constexpr int RING_OFF = 0, RING_BYTES = 131072, LDS_BYTES = 147456, LDSCTL_OFF = LDS_BYTES - 1024, MISC_OFF = LDSCTL_OFF + 320;

__device__ __forceinline__ float bf2f(bf16 b) { return __uint_as_float((unsigned)b << 16); }
__device__ __forceinline__ float wave_sum(float v) {
#define WS_DPP(x, ctrl, rmask) __builtin_bit_cast(float, __builtin_amdgcn_update_dpp(0, __builtin_bit_cast(int, (x)), (ctrl), (rmask), 0xF, false))
    v += WS_DPP(v, 0xB1, 0xF);
    v += WS_DPP(v, 0x4E, 0xF);
    v += WS_DPP(v, 0x141, 0xF);
    v += WS_DPP(v, 0x140, 0xF);
    v += WS_DPP(v, 0x142, 0xA);
    v += WS_DPP(v, 0x143, 0xC);
#undef WS_DPP
    return __builtin_bit_cast(float, __builtin_amdgcn_readlane(__builtin_bit_cast(int, v), 63));
}
__device__ __forceinline__ float sigmoidf_(float x) { return __builtin_amdgcn_rcpf(1.f + __expf(-x)); }

struct Frame {
    LAS unsigned char* lds;
    volatile LAS unsigned* MISC;
    gu32* ctl;
    int tid, lane, wave, vcu, G;
    const float *xp, *xs, *cache_k, *cache_v, *state_conv, *state_ssm, *norm_mix_w, *w_in, *sb_bias, *conv_w, *a_log, *dt_bias, *gdn_norm_w, *w_pa, *w_pb, *w_o, *norm_mlp_w, *w_up, *w_down, *norm_final_w;
    const int* page_table;
    float* out; unsigned char* ws;
};
#define WSP(T, off) ((T*)(F.ws + (off)))

struct StaticOrder {
    int nM, nN, nwg, G, c;
    __device__ void init(int M_, int N_, int G_, int c_) { nM = M_ / pg8::BM; nN = N_ / pg8::BM; nwg = nM * nN; G = G_; c = c_; }
    __device__ bool next(int i, pg8::Unit& u) const {
        const long L = (long)i * G + c; if (L >= nwg) return false;
        int wgid = (int)L; { const int q = nwg / pg8::NXCD, r = nwg % pg8::NXCD, xcd = wgid % pg8::NXCD, off = wgid / pg8::NXCD; wgid = (xcd < r ? xcd * (q + 1) : r * (q + 1) + (xcd - r) * q) + off; }
        const int nig = pg8::WGM * nN, gid = wgid / nig, fm = gid * pg8::WGM, gsz = (nM - fm) < pg8::WGM ? (nM - fm) : pg8::WGM;
        u.pm = fm + ((wgid % nig) % gsz); u.pn = (wgid % nig) / gsz; u.ko = 0; u.nk = 0; return true;
    }
    __device__ __forceinline__ void a_ready(const pg8::Unit&) const {}
    __device__ __forceinline__ void done(const pg8::Unit&) const {}
};
struct MergeOrder {
    int G, c, ntile;
    __device__ bool next(int i, pg8::Unit& u) const { const int t = (i >> 1) * G + c; if (t >= ntile) return false; u.pm = t >> 2; u.pn = t & 3; u.ko = (i & 1) * 512; u.nk = 0; return true; }
    __device__ __forceinline__ void a_ready(const pg8::Unit&) const {}
    __device__ __forceinline__ void done(const pg8::Unit&) const {}
};

struct DownOrder {
    StaticOrder P; int c;
    __device__ bool next(int i, pg8::Unit& u) const {
        const int np = c < P.nwg ? (P.nwg - 1 - c) / P.G + 1 : 0;
        if (i < np) return P.next(i, u);
        const int su = (i - np) * P.G + c; if (su >= 128) return false;
        u.pm = MP / 256 + (su >> 6); u.pn = (su >> 4) & 3; u.ko = 256 * (su & 15); u.nk = 4; return true; }
    __device__ __forceinline__ void a_ready(const pg8::Unit&) const {}
    __device__ __forceinline__ void done(const pg8::Unit&) const {}
};
typedef pg8::f32x4 a4;
#define EPI_LOOP_BEGIN const int row0 = u.pm * 256 + wr * 64 + fr; const int cw = wc * 32 + 8 * fq; \
    _Pragma("unroll") for (int ai = 0; ai < 2; ++ai) _Pragma("unroll") for (int m = 0; m < 4; ++m) { const int row = row0 + ai * 128 + m * 16; \
    _Pragma("unroll") for (int bj = 0; bj < 2; ++bj) { const int col = u.pn * 256 + bj * 128 + cw; a4 v0 = acc[ai][bj][m][0], v1 = acc[ai][bj][m][1];
#define EPI_LOOP_END } }
__device__ __forceinline__ v4u pack8(a4 v0, a4 v1) { v4u w; w.x = pg8::cvt_pk_bf16(v0[0], v0[1]); w.y = pg8::cvt_pk_bf16(v0[2], v0[3]); w.z = pg8::cvt_pk_bf16(v1[0], v1[1]); w.w = pg8::cvt_pk_bf16(v1[2], v1[3]); return w; }
__device__ __forceinline__ void unpack8(v4u w, a4& v0, a4& v1) {
    v0[0] = __uint_as_float(w.x << 16); v0[1] = __uint_as_float(w.x & 0xffff0000u); v0[2] = __uint_as_float(w.y << 16); v0[3] = __uint_as_float(w.y & 0xffff0000u);
    v1[0] = __uint_as_float(w.z << 16); v1[1] = __uint_as_float(w.z & 0xffff0000u); v1[2] = __uint_as_float(w.w << 16); v1[3] = __uint_as_float(w.w & 0xffff0000u); }

struct EpiIn {
    static constexpr bool PERM = true, AFTER_DRAIN = false; static constexpr int MIDK = 0;
    bf16 *Qa, *Ka, *Va, *Zb, *GA, *GB; float* U; float* out;
    __device__ __forceinline__ void operator()(const a4 (&acc)[2][2][4][2], const pg8::Unit& u, int wr, int wc, int fr, int fq) const {
        const int pn = u.pn;
        EPI_LOOP_BEGIN
            if (pn < 2) { *(v4u*)(Qa + (size_t)row * 512 + col) = pack8(v0 * QSCALE, v1 * QSCALE); }
            else if (pn < 6) { const bool isk = pn < 4; const int cc = col - (isk ? 512 : 1024);
                float* o = out + (row < MP ? (isk ? O_KP : O_VP) + (size_t)row * 512 : (isk ? O_KS : O_VS) + (size_t)(row - MP) * 512) + cc;
                if (row < MP) { __builtin_nontemporal_store(v0, (a4*)o); __builtin_nontemporal_store(v1, (a4*)(o + 4)); } else { *(a4*)o = v0; *(a4*)(o + 4) = v1; }
                *(v4u*)((isk ? Ka : Va) + (size_t)row * 512 + cc) = pack8(v0, v1); }
            else if (pn < 12) { float* o = U + (size_t)row * CONVD + (col - 1536); *(a4*)o = v0; *(a4*)(o + 4) = v1; }
            else if (pn < 14) { *(v4u*)(Zb + (size_t)row * 512 + (col - 3072)) = pack8(v0, v1); }
            else { const bool isa = pn < 18; const int cc = col - (isa ? 3584 : 4608);
#pragma unroll
                for (int e = 0; e < 4; ++e) { v0[e] = sigmoidf_(v0[e]); v1[e] = sigmoidf_(v1[e]); }
                *(v4u*)((isa ? GA : GB) + (size_t)row * DM + cc) = pack8(v0, v1); }
        EPI_LOOP_END
    }
};
struct EpiMerge {
    static constexpr bool PERM = true, AFTER_DRAIN = false; static constexpr int MIDK = 8;
    const bf16 *GA, *GB; bf16* Mb;
    __device__ __forceinline__ void operator()(a4 (&acc)[2][2][4][2], const pg8::Unit& u, int wr, int wc, int fr, int fq) const {
        const int row0 = u.pm * 256 + wr * 64 + fr, cw = u.pn * 256 + wc * 32 + 8 * fq;
        if (u.ko == 0) {
#pragma unroll
            for (int ai = 0; ai < 2; ++ai) {
                v4u gb[4][2], ga[4][2];
#pragma unroll
                for (int m = 0; m < 4; ++m)
#pragma unroll
                    for (int bj = 0; bj < 2; ++bj) { const size_t idx = (size_t)(row0 + ai * 128 + m * 16) * DM + cw + bj * 128; gb[m][bj] = *(const GAS v4u*)(GB + idx); ga[m][bj] = *(const GAS v4u*)(GA + idx); }
#pragma unroll
                for (int m = 0; m < 4; ++m)
#pragma unroll
                    for (int bj = 0; bj < 2; ++bj) { a4 b0, b1, a0, a1; unpack8(gb[m][bj], b0, b1); unpack8(ga[m][bj], a0, a1);
#pragma unroll
                        for (int e = 0; e < 4; ++e) { acc[ai][bj][m][0][e] *= a0[e] * __builtin_amdgcn_rcpf(fmaxf(b0[e], 1e-30f)); acc[ai][bj][m][1][e] *= a1[e] * __builtin_amdgcn_rcpf(fmaxf(b1[e], 1e-30f)); } }
            }
        } else {
#pragma unroll
            for (int ai = 0; ai < 2; ++ai) {
                v4u gb[4][2];
#pragma unroll
                for (int m = 0; m < 4; ++m)
#pragma unroll
                    for (int bj = 0; bj < 2; ++bj) gb[m][bj] = *(const GAS v4u*)(GB + (size_t)(row0 + ai * 128 + m * 16) * DM + cw + bj * 128);
#pragma unroll
                for (int m = 0; m < 4; ++m)
#pragma unroll
                    for (int bj = 0; bj < 2; ++bj) { a4 b0, b1; unpack8(gb[m][bj], b0, b1);
                        *(v4u*)(Mb + (size_t)(row0 + ai * 128 + m * 16) * DM + cw + bj * 128) = pack8(acc[ai][bj][m][0] * b0, acc[ai][bj][m][1] * b1); }
            }
        }
    }
};
struct EpiRes {
    static constexpr bool PERM = true, AFTER_DRAIN = false; static constexpr int MIDK = 0;
    const float *baseP, *baseS; float* Rf; bf16* Rb; float* SS;
    __device__ __forceinline__ void operator()(const a4 (&acc)[2][2][4][2], const pg8::Unit& u, int wr, int wc, int fr, int fq) const {
        const int row0 = u.pm * 256 + wr * 64 + fr, cw = u.pn * 256 + wc * 32 + 8 * fq;
#pragma unroll
        for (int ai = 0; ai < 2; ++ai) {
            a4 b[4][2][2];
#pragma unroll
            for (int m = 0; m < 4; ++m)
#pragma unroll
                for (int bj = 0; bj < 2; ++bj) { const int row = row0 + ai * 128 + m * 16;
                    const GAS float* p = (const GAS float*)(row < MP ? baseP + (size_t)row * DM : baseS + (size_t)(row - MP) * DM) + cw + bj * 128; b[m][bj][0] = *(const GAS a4*)p; b[m][bj][1] = *(const GAS a4*)(p + 4); }
#pragma unroll
            for (int m = 0; m < 4; ++m) { const int row = row0 + ai * 128 + m * 16; float ss = 0.f;
#pragma unroll
                for (int bj = 0; bj < 2; ++bj) { const a4 r0 = b[m][bj][0] + acc[ai][bj][m][0], r1 = b[m][bj][1] + acc[ai][bj][m][1]; const size_t idx = (size_t)row * DM + cw + bj * 128;
                    *(a4*)(Rf + idx) = r0; *(a4*)(Rf + idx + 4) = r1; if (Rb) *(v4u*)(Rb + idx) = pack8(r0, r1);
                    ss += (r0[0] * r0[0] + r0[1] * r0[1]) + (r0[2] * r0[2] + r0[3] * r0[3]) + (r1[0] * r1[0] + r1[1] * r1[1]) + (r1[2] * r1[2] + r1[3] * r1[3]); }
                ss += __shfl_xor(ss, 16); ss += __shfl_xor(ss, 32);
                if (fq == 0) __hip_atomic_fetch_add(SS + row, ss, __ATOMIC_RELAXED, __HIP_MEMORY_SCOPE_AGENT); }
        }
    }
};
struct EpiDown {
    static constexpr bool PERM = true, AFTER_DRAIN = false; static constexpr int MIDK = 0;
    const float* X1; float* Y;
    __device__ __forceinline__ void operator()(const a4 (&acc)[2][2][4][2], const pg8::Unit& u, int wr, int wc, int fr, int fq) const {
        const int row0 = u.pm * 256 + wr * 64 + fr, cw = u.pn * 256 + wc * 32 + 8 * fq;
#pragma unroll
        for (int ai = 0; ai < 2; ++ai) {
            a4 b[4][2][2];
#pragma unroll
            for (int m = 0; m < 4; ++m)
#pragma unroll
                for (int bj = 0; bj < 2; ++bj) { const GAS float* p = (const GAS float*)X1 + (size_t)(row0 + ai * 128 + m * 16) * DM + cw + bj * 128; b[m][bj][0] = *(const GAS a4*)p; b[m][bj][1] = *(const GAS a4*)(p + 4); }
#pragma unroll
            for (int m = 0; m < 4; ++m)
#pragma unroll
                for (int bj = 0; bj < 2; ++bj) { float* o = Y + (size_t)(row0 + ai * 128 + m * 16) * DM + cw + bj * 128; *(a4*)o = b[m][bj][0] + acc[ai][bj][m][0]; *(a4*)(o + 4) = b[m][bj][1] + acc[ai][bj][m][1]; }
        }
    }
};
__device__ __forceinline__ void wait_count(gu32* cnt, unsigned need) {
    unsigned spins = 0;
    while (__hip_atomic_load(cnt, __ATOMIC_RELAXED, __HIP_MEMORY_SCOPE_AGENT) < need) { __builtin_amdgcn_s_sleep(2); if (++spins > (1u << 22)) break; }
}
struct EpiDownF {
    static constexpr bool PERM = true, AFTER_DRAIN = true; static constexpr int MIDK = 0;
    const float* X1; float* Y; float* SS; gu32* cnt; const float* nw;
    __device__ __forceinline__ void operator()(const a4 (&acc)[2][2][4][2], const pg8::Unit& u, int wr, int wc, int fr, int fq) const {}
    __device__ __forceinline__ void fused(const a4 (&acc)[2][2][4][2], const pg8::Unit& u, int wr, int wc, int fr, int fq, LAS unsigned char* lds, int wid, int lane) const {
        const int row0 = u.pm * 256 + wr * 64 + fr, cw = u.pn * 256 + wc * 32 + 8 * fq;
#pragma unroll
        for (int ai = 0; ai < 2; ++ai) {
            a4 b[4][2][2];
#pragma unroll
            for (int m = 0; m < 4; ++m)
#pragma unroll
                for (int bj = 0; bj < 2; ++bj) { const GAS float* p = (const GAS float*)X1 + (size_t)(row0 + ai * 128 + m * 16) * DM + cw + bj * 128; b[m][bj][0] = *(const GAS a4*)p; b[m][bj][1] = *(const GAS a4*)(p + 4); }
#pragma unroll
            for (int m = 0; m < 4; ++m) { float ss = 0.f;
#pragma unroll
                for (int bj = 0; bj < 2; ++bj) { const a4 r0 = b[m][bj][0] + acc[ai][bj][m][0], r1 = b[m][bj][1] + acc[ai][bj][m][1];
                    ss += (r0[0] * r0[0] + r0[1] * r0[1]) + (r0[2] * r0[2] + r0[3] * r0[3]) + (r1[0] * r1[0] + r1[1] * r1[1]) + (r1[2] * r1[2] + r1[3] * r1[3]); }
                ss += __shfl_xor(ss, 16); ss += __shfl_xor(ss, 32);
                if (fq == 0) __hip_atomic_fetch_add(SS + (row0 + ai * 128 + m * 16), ss, __ATOMIC_RELAXED, __HIP_MEMORY_SCOPE_AGENT); }
        }
        asm volatile("s_waitcnt vmcnt(0)" ::: "memory");
        __syncthreads();
        if (threadIdx.x == 0) { __hip_atomic_fetch_add(cnt + 64 * u.pm, 1u, __ATOMIC_RELAXED, __HIP_MEMORY_SCOPE_AGENT); wait_count(cnt + 64 * u.pm, 4u); }
        __syncthreads();
        float rs[2][4];
#pragma unroll
        for (int ai = 0; ai < 2; ++ai)
#pragma unroll
            for (int m = 0; m < 4; ++m) rs[ai][m] = __hip_atomic_load(SS + (row0 + ai * 128 + m * 16), __ATOMIC_RELAXED, __HIP_MEMORY_SCOPE_AGENT);
        a4 w[2][2];
#pragma unroll
        for (int bj = 0; bj < 2; ++bj) { w[bj][0] = *(const GAS a4*)(nw + cw + bj * 128); w[bj][1] = *(const GAS a4*)(nw + cw + bj * 128 + 4); }
#pragma unroll
        for (int ai = 0; ai < 2; ++ai) {
            a4 b[4][2][2];
#pragma unroll
            for (int m = 0; m < 4; ++m)
#pragma unroll
                for (int bj = 0; bj < 2; ++bj) { const GAS float* p = (const GAS float*)X1 + (size_t)(row0 + ai * 128 + m * 16) * DM + cw + bj * 128; b[m][bj][0] = *(const GAS a4*)p; b[m][bj][1] = *(const GAS a4*)(p + 4); }
#pragma unroll
            for (int m = 0; m < 4; ++m) { const float r = 1.f / sqrtf(rs[ai][m] * (1.f / DM) + NORM_EPS);
#pragma unroll
                for (int bj = 0; bj < 2; ++bj) { float* o = Y + (size_t)(row0 + ai * 128 + m * 16) * DM + cw + bj * 128;
                    __builtin_nontemporal_store((b[m][bj][0] + acc[ai][bj][m][0]) * r * w[bj][0], (a4*)o); __builtin_nontemporal_store((b[m][bj][1] + acc[ai][bj][m][1]) * r * w[bj][1], (a4*)(o + 4)); } }
        }
    }
};
struct EpiUp {
    static constexpr bool PERM = true, AFTER_DRAIN = false; static constexpr int MIDK = 0;
    const float* SS; bf16* H;
    __device__ __forceinline__ void operator()(const a4 (&acc)[2][2][4][2], const pg8::Unit& u, int wr, int wc, int fr, int fq) const {
        float rs[2][4];
#pragma unroll
        for (int ai = 0; ai < 2; ++ai)
#pragma unroll
            for (int m = 0; m < 4; ++m) rs[ai][m] = __hip_atomic_load(SS + (u.pm * 256 + wr * 64 + fr + ai * 128 + m * 16), __ATOMIC_RELAXED, __HIP_MEMORY_SCOPE_AGENT);
#pragma unroll
        for (int ai = 0; ai < 2; ++ai)
#pragma unroll
            for (int m = 0; m < 4; ++m) rs[ai][m] = __builtin_amdgcn_rsqf(rs[ai][m] * (1.f / DM) + NORM_EPS);
        EPI_LOOP_BEGIN
            const float r = rs[ai][m];
#pragma unroll
            for (int e = 0; e < 4; ++e) { float a = fmaxf(v0[e] * r, 0.f), b = fmaxf(v1[e] * r, 0.f); v0[e] = a * a; v1[e] = b * b; }
            *(v4u*)(H + (size_t)row * FF + col) = pack8(v0, v1);
        EPI_LOOP_END
    }
};

__device__ __forceinline__ void p0_transpose_item(const float* W, int ldw, int nblk, bf16* WT, int ldt, int koff, const float* kscale, int shift_from, int shift, LAS float* scr, int item, int lane) {
    const int kb = item / nblk, nb = item % nblk, k0 = 64 * kb, n0 = 32 * nb, ns = n0 + (n0 >= shift_from ? shift : 0);
    const GAS float* Wg = (const GAS float*)W + (size_t)(k0 + (lane >> 5)) * ldw + ns + (lane & 31);
    float wv[32], sv[32];
#pragma unroll
    for (int i = 0; i < 32; ++i) wv[i] = __builtin_nontemporal_load(Wg + (size_t)(2 * i) * ldw);
    if (kscale) {
#pragma unroll
        for (int i = 0; i < 32; ++i) sv[i] = ((const GAS float*)kscale)[k0 + 2 * i + (lane >> 5)];
#pragma unroll
        for (int i = 0; i < 32; ++i) wv[i] *= sv[i];
    }
#pragma unroll
    for (int i = 0; i < 32; ++i) scr[(2 * i + (lane >> 5)) * 33 + (lane & 31)] = wv[i];
    LDS_WAIT(); asm volatile("" ::: "memory");
    const int c = lane & 7;
#pragma unroll
    for (int j = 0; j < 4; ++j) { const int n = (lane >> 3) + 8 * j; const LAS float* s = scr + (8 * c) * 33 + n;
        v4u o; o.x = pk2(s[0 * 33], s[1 * 33]); o.y = pk2(s[2 * 33], s[3 * 33]); o.z = pk2(s[4 * 33], s[5 * 33]); o.w = pk2(s[6 * 33], s[7 * 33]);
        *(GAS v4u*)(WT + (size_t)(n0 + n) * ldt + koff + k0 + 8 * c) = o; }
    LDS_WAIT(); asm volatile("" ::: "memory");
}
__device__ __forceinline__ void p0_prologue(Frame& F, unsigned long long& ts_mid) {
    LAS float* scr = (LAS float*)(F.lds + RING_OFF + F.wave * 12288);
    const int gw = F.vcu * NWAVES + F.wave, NGW = F.G * NWAVES, lane = F.lane;
    constexpr int I_IN = (DM / 64) * (NIN / 32), I_PA = (512 / 64) * (DM / 32), I_O = (DM / 64) * (DM / 32), I_UP = (DM / 64) * (FF / 32), I_DN = (FF / 64) * (DM / 32);
    constexpr int NITEMS = I_IN + 2 * I_PA + I_O + I_UP + I_DN;
    for (int it = gw; it < NITEMS; it += NGW) {
        int r = it;
        if (r < I_IN) { p0_transpose_item(F.w_in, INW, NIN / 32, WSP(bf16, WS_WIN), DM, 0, F.norm_mix_w, 3584, 8, scr, r, lane); continue; } r -= I_IN;
        if (r < I_PA) { p0_transpose_item(F.w_pa, DM, DM / 32, WSP(bf16, WS_WCAT), DM, 0, nullptr, 1 << 30, 0, scr, r, lane); continue; } r -= I_PA;
        if (r < I_PA) { p0_transpose_item(F.w_pb, DM, DM / 32, WSP(bf16, WS_WCAT), DM, 512, nullptr, 1 << 30, 0, scr, r, lane); continue; } r -= I_PA;
        if (r < I_O) { p0_transpose_item(F.w_o, DM, DM / 32, WSP(bf16, WS_WO), DM, 0, nullptr, 1 << 30, 0, scr, r, lane); continue; } r -= I_O;
        if (r < I_UP) { p0_transpose_item(F.w_up, FF, FF / 32, WSP(bf16, WS_WUP), DM, 0, F.norm_mlp_w, 1 << 30, 0, scr, r, lane); continue; } r -= I_UP;
        p0_transpose_item(F.w_down, DM, DM / 32, WSP(bf16, WS_WDN), FF, 0, nullptr, 1 << 30, 0, scr, r, lane);
    }
    __syncthreads();
    if (PROBE_WAIT_PHASE == 200 || PROBE_WAIT_PHASE == 201) ts_mid = __builtin_amdgcn_s_memrealtime();
    {
        LAS f32x4* wl = (LAS f32x4*)(F.lds + RING_OFF + 98304);
#pragma unroll
        for (int i = 0; i < 2; ++i) { const int k = F.tid + 512 * i; const float nw = F.norm_mix_w[k]; const float* wp = F.w_in + (size_t)k * INW + 3584;
            wl[2 * k] = *(const f32x4*)wp * nw; wl[2 * k + 1] = *(const f32x4*)(wp + 4) * nw; }
    }
    __syncthreads();
    f32x4 wab[4][4][2];
#pragma unroll
    for (int jj = 0; jj < 4; ++jj)
#pragma unroll
        for (int e = 0; e < 4; ++e) { const int k = 256 * jj + 4 * lane + e; const LAS f32x4* wl = (const LAS f32x4*)(F.lds + RING_OFF + 98304);
            wab[jj][e][0] = wl[2 * k]; wab[jj][e][1] = wl[2 * k + 1]; }
    bf16* XN = WSP(bf16, WS_XN); float* AB = WSP(float, WS_AB);
#define P0_XROW(m) ((const GAS f32x4*)((m) < MP ? F.xp + (size_t)(m) * DM : F.xs + (size_t)((m) - MP) * DM) + lane)
    f32x4 vn[4];
    if (gw < M) {
#pragma unroll
        for (int j = 0; j < 4; ++j) vn[j] = __builtin_nontemporal_load(P0_XROW(gw) + 64 * j); }
    for (int m = gw; m < M; m += NGW) {
        f32x4 v[4]; float s = 0.f;
#pragma unroll
        for (int j = 0; j < 4; ++j) v[j] = vn[j];
        if (m + NGW < M) {
#pragma unroll
            for (int j = 0; j < 4; ++j) vn[j] = __builtin_nontemporal_load(P0_XROW(m + NGW) + 64 * j); }
#pragma unroll
        for (int j = 0; j < 4; ++j) s += (v[j].x * v[j].x + v[j].y * v[j].y) + (v[j].z * v[j].z + v[j].w * v[j].w);
        const float rstd = 1.f / sqrtf(wave_sum(s) * (1.f / DM) + NORM_EPS);
        GAS unsigned long long* o8 = (GAS unsigned long long*)(XN + (size_t)m * DM) + lane;
        f32x4 d0 = {0.f, 0.f, 0.f, 0.f}, d1 = {0.f, 0.f, 0.f, 0.f};
#pragma unroll
        for (int j = 0; j < 4; ++j) { v[j] = v[j] * rstd;
            o8[64 * j] = (unsigned long long)pk2(v[j].x, v[j].y) | ((unsigned long long)pk2(v[j].z, v[j].w) << 32);
#pragma unroll
            for (int e = 0; e < 4; ++e) { d0 += wab[j][e][0] * v[j][e]; d1 += wab[j][e][1] * v[j][e]; } }
        { float t[8] = {d0[0], d0[1], d0[2], d0[3], d1[0], d1[1], d1[2], d1[3]};
          const bool u5 = lane & 32, u4 = lane & 16, u3 = lane & 8;
          float a[4];
#pragma unroll
          for (int i = 0; i < 4; ++i) { const float keep = u5 ? t[4 + i] : t[i], give = u5 ? t[i] : t[4 + i]; a[i] = keep + __shfl_xor(give, 32); }
          float b2[2];
#pragma unroll
          for (int i = 0; i < 2; ++i) { const float keep = u4 ? a[2 + i] : a[i], give = u4 ? a[i] : a[2 + i]; b2[i] = keep + __shfl_xor(give, 16); }
          float c1; { const float keep = u3 ? b2[1] : b2[0], give = u3 ? b2[0] : b2[1]; c1 = keep + __shfl_xor(give, 8); }
          c1 += __shfl_xor(c1, 4); c1 += __shfl_xor(c1, 2); c1 += __shfl_xor(c1, 1);
          if ((lane & 7) == 0) AB[(size_t)m * 8 + ((lane >> 5) & 1) * 4 + ((lane >> 4) & 1) * 2 + ((lane >> 3) & 1)] = c1; }
    }
#undef P0_XROW
}

__device__ __forceinline__ void p2_gdn_prep(Frame& F) {
    const int gw = F.vcu * NWAVES + F.wave, NGW = F.G * NWAVES, lane = F.lane;
    const float* U = WSP(float, WS_U); float* QKVN = WSP(float, WS_QKVN); const float* AB = WSP(float, WS_AB); float* GBETA = WSP(float, WS_GBETA);
    typedef float f2 __attribute__((ext_vector_type(2)));
    for (int it = MP * GH + gw; it < M * GH; it += NGW) {
        const int row = it >> 2, h = it & 3;
        int t, seq; bool prompt = row < MP; if (prompt) { seq = row / TP; t = row % TP; } else { seq = (row - MP) >> 2; t = (row - MP) & 3; }
        f2 cv[3];
#pragma unroll
        for (int p = 0; p < 3; ++p) {
            const int ch = p * 512 + h * 128 + 2 * lane; f2 acc = {0.f, 0.f};
#pragma unroll
            for (int w = 0; w < 4; ++w) {
                const int tt = t - 3 + w; f2 uv;
                if (tt >= 0) uv = *(const f2*)(U + (size_t)(row - 3 + w) * CONVD + ch);
                else if (prompt) uv = (f2){0.f, 0.f};
                else uv = *(const f2*)(F.state_conv + ((size_t)seq * 3 + (tt + 3)) * CONVD + ch);
                const f2 cw = *(const f2*)(F.conv_w + (size_t)w * CONVD + ch);
                acc += uv * cw;
            }
            acc.x = acc.x * sigmoidf_(acc.x); acc.y = acc.y * sigmoidf_(acc.y);
            cv[p] = acc;
            const int tl = prompt ? TP : TS;
            if (t >= tl - 3) { const f2 uv = *(const f2*)(U + (size_t)row * CONVD + ch); const int i = t - (tl - 3);
                float* o = F.out + (prompt ? O_CP + ((size_t)seq * 3 + i) * CONVD : O_CS + ((size_t)seq * 3 + i) * CONVD) + ch; *(f2*)o = uv; }
        }
        const float sq = wave_sum(cv[0].x * cv[0].x + cv[0].y * cv[0].y), sk = wave_sum(cv[1].x * cv[1].x + cv[1].y * cv[1].y);
        const float rq = __builtin_amdgcn_rsqf(sq + L2_EPS) * 0.08838834764831845f, rk = __builtin_amdgcn_rsqf(sk + L2_EPS);
        float* o = QKVN + (size_t)row * CONVD + h * 128 + 2 * lane;
        *(f2*)o = cv[0] * rq; *(f2*)(o + 512) = cv[1] * rk; *(f2*)(o + 1024) = cv[2];
        if (lane == 0) { const float a = AB[(size_t)row * 8 + h] + F.dt_bias[h], b = AB[(size_t)row * 8 + 4 + h];
            const float sp = a > 20.f ? a : log1pf(__expf(a));
            GBETA[(size_t)row * 8 + h] = -__expf(F.a_log[h]) * sp; GBETA[(size_t)row * 8 + 4 + h] = sigmoidf_(b); }
    }
}


__device__ __forceinline__ void conv_rows8(Frame& F, size_t row0, int t0, int seq, int h, int lane, LAS unsigned char* img  , LAS float* scc, int lr0  ) {
    typedef float f2 __attribute__((ext_vector_type(2)));
    const float* U = WSP(float, WS_U); float* QKVN = WSP(float, WS_QKVN); const float* AB = WSP(float, WS_AB); float* GBETA = WSP(float, WS_GBETA);
    float ga = 0.f, gb = 0.f;
    if (lane < 8) { ga = AB[(row0 + lane) * 8 + h] + F.dt_bias[h]; gb = AB[(row0 + lane) * 8 + 4 + h]; }
#pragma unroll
    for (int p = 0; p < 3; ++p) {
        const int ch = p * 512 + h * 128 + 2 * lane;
        f2 u[11], cw[4];
#pragma unroll
        for (int i = 0; i < 11; ++i) u[i] = __builtin_nontemporal_load((const GAS f2*)(U + (row0 + i >= 3 ? row0 + i - 3 : 0) * CONVD + ch));
#pragma unroll
        for (int i = 0; i < 3; ++i) if (t0 - 3 + i < 0) u[i] = (f2){0.f, 0.f};
#pragma unroll
        for (int w = 0; w < 4; ++w) cw[w] = *(const f2*)(F.conv_w + (size_t)w * CONVD + ch);
#pragma unroll
        for (int r = 0; r < 8; ++r) {
            f2 acc = u[r] * cw[0] + u[r + 1] * cw[1] + u[r + 2] * cw[2] + u[r + 3] * cw[3];
            acc.x = acc.x * sigmoidf_(acc.x); acc.y = acc.y * sigmoidf_(acc.y);
            float sc = 1.f;
            if (p < 2) { const float ss = wave_sum(acc.x * acc.x + acc.y * acc.y); sc = __builtin_amdgcn_rsqf(ss + L2_EPS) * (p == 0 ? 0.08838834764831845f : 1.f); }
            { const f2 y = acc * sc; *(LAS unsigned*)(img + (p == 0 ? 17408 : p == 1 ? 0 : 104448) + (lr0 + r) * 272 + 4 * lane) = pg8::cvt_pk_bf16(y.x, y.y); }
            if (t0 + r >= TP - 3) *(f2*)(F.out + O_CP + ((size_t)seq * 3 + (t0 + r - (TP - 3))) * CONVD + ch) = u[r + 3];
        }
    }
    if (lane < 8) { const float sp = ga > 20.f ? ga : log1pf(__expf(ga));
        scc[lr0 + lane] = -__expf(F.a_log[h]) * sp; scc[64 + lr0 + lane] = sigmoidf_(gb); }
}
__device__ __forceinline__ unsigned long long gdn_pk4(float a, float b, float c, float d) { return (unsigned long long)pg8::cvt_pk_bf16(a, b) | ((unsigned long long)pg8::cvt_pk_bf16(c, d) << 32); }
namespace sba {
typedef float f32x16 __attribute__((ext_vector_type(16)));
typedef short s16x4 __attribute__((ext_vector_type(4)));
typedef short v4i16_t __attribute__((ext_vector_type(4)));
typedef __attribute__((address_space(3))) const unsigned char* lptr;
constexpr int SLOTB = 8192;
constexpr int L_K = 0, L_V = 4 * SLOTB, L_STG = 8 * SLOTB, L_END = L_STG + NWAVES * 4096;

__device__ __forceinline__ s16x4 vtr(lptr p) { return __builtin_bit_cast(s16x4, __builtin_amdgcn_ds_read_tr16_b64_v4i16((__attribute__((address_space(3))) v4i16_t*)p)); }
__device__ __forceinline__ bf16x8 pack8f(float a, float b, float c, float d, float e, float f, float g, float h) {
    v4u w; w.x = pg8::cvt_pk_bf16(a, b); w.y = pg8::cvt_pk_bf16(c, d); w.z = pg8::cvt_pk_bf16(e, f); w.w = pg8::cvt_pk_bf16(g, h); return __builtin_bit_cast(bf16x8, w); }

__device__ __forceinline__ float mulv(float a, float b) { float r; asm("v_mul_f32_e32 %0, %1, %2" : "=v"(r) : "v"(a), "v"(b)); return r; }
#define HZ_FENCE8(x, o) asm volatile("s_nop 1" : "+v"(x[o]), "+v"(x[o + 1]), "+v"(x[o + 2]), "+v"(x[o + 3]), "+v"(x[o + 4]), "+v"(x[o + 5]), "+v"(x[o + 6]), "+v"(x[o + 7]))
#define HZ_FENCE16(x) asm volatile("s_nop 1" : "+v"(x[0]), "+v"(x[1]), "+v"(x[2]), "+v"(x[3]), "+v"(x[4]), "+v"(x[5]), "+v"(x[6]), "+v"(x[7]), "+v"(x[8]), "+v"(x[9]), "+v"(x[10]), "+v"(x[11]), "+v"(x[12]), "+v"(x[13]), "+v"(x[14]), "+v"(x[15]))
template <int NB, bool MASK> __device__ __forceinline__ void weights(f32x16 (&p)[NB], float& R, int hi, int lim) {
    float om[NB][16];
    const int lim0 = lim - 4 * hi;
#pragma unroll
    for (int blk = 0; blk < NB; ++blk)
#pragma unroll
        for (int r = 0; r < 16; ++r) {
            const int c = (r & 3) + 8 * (r >> 2) + 32 * blk;
            float z = p[blk][r];
            if (MASK) { if (!(c < lim0)) z = -INFINITY; }
            const float e = __builtin_amdgcn_exp2f(z);
            om[blk][r] = __builtin_amdgcn_rcpf(1.f + e);
            p[blk][r] = e;
        }
#pragma unroll
    for (int blk = 0; blk < NB; ++blk) { HZ_FENCE16(om[blk]); HZ_FENCE16(p[blk]); }
    float G[4 * NB], sel[4 * NB], A[4 * NB], B[4 * NB];
#pragma unroll
    for (int k = 0; k < 4 * NB; ++k) { const int blk = k >> 2, g = k & 3; float t;
        asm("v_mul_f32_e32 %0, %2, %3\n\tv_mul_f32_e32 %1, %4, %5\n\tv_mul_f32_e32 %0, %0, %1" : "=&v"(G[k]), "=&v"(t) : "v"(om[blk][4 * g]), "v"(om[blk][4 * g + 1]), "v"(om[blk][4 * g + 2]), "v"(om[blk][4 * g + 3])); }
    if constexpr (NB == 2) HZ_FENCE8(G, 0);
    if constexpr (NB == 1) asm volatile("s_nop 1" : "+v"(G[0]), "+v"(G[1]), "+v"(G[2]), "+v"(G[3]));
#pragma unroll
    for (int k = 0; k < 4 * NB; ++k) { auto rr = __builtin_amdgcn_permlane32_swap(__float_as_uint(G[k]), __float_as_uint(G[k]), false, false);
        A[k] = __uint_as_float(rr[0]); B[k] = __uint_as_float(rr[1]); }
    if constexpr (NB == 2) asm volatile("s_nop 1" : "+v"(A[0]), "+v"(A[1]), "+v"(A[2]), "+v"(A[3]), "+v"(A[4]), "+v"(A[5]), "+v"(A[6]), "+v"(A[7]), "+v"(B[0]), "+v"(B[1]), "+v"(B[2]), "+v"(B[3]), "+v"(B[4]), "+v"(B[5]), "+v"(B[6]), "+v"(B[7]));
    if constexpr (NB == 1) { asm volatile("s_nop 1" : "+v"(A[0]), "+v"(A[1]), "+v"(A[2]), "+v"(A[3]), "+v"(B[0]), "+v"(B[1]), "+v"(B[2]), "+v"(B[3])); }
#pragma unroll
    for (int k = 0; k < 4 * NB; ++k) sel[k] = hi ? 1.f : B[k];
    float E = R;
#pragma unroll
    for (int k = 4 * NB - 1; k >= 0; --k) {
        const int blk = k >> 2, r0 = 4 * (k & 3); float P;
        asm("v_mul_f32_e32 %0, %5, %6\n\t"
            "v_mul_f32_e32 %0, %0, %10\n\tv_mul_f32_e32 %4, %4, %0\n\t"
            "v_mul_f32_e32 %0, %0, %9\n\tv_mul_f32_e32 %3, %3, %0\n\t"
            "v_mul_f32_e32 %0, %0, %8\n\tv_mul_f32_e32 %2, %2, %0\n\t"
            "v_mul_f32_e32 %0, %0, %7\n\tv_mul_f32_e32 %1, %1, %0\n\t"
            "v_mul_f32_e32 %5, %5, %11\n\tv_mul_f32_e32 %5, %5, %12"
            : "=&v"(P), "+v"(p[blk][r0]), "+v"(p[blk][r0 + 1]), "+v"(p[blk][r0 + 2]), "+v"(p[blk][r0 + 3]), "+v"(E)
            : "v"(sel[k]), "v"(om[blk][r0]), "v"(om[blk][r0 + 1]), "v"(om[blk][r0 + 2]), "v"(om[blk][r0 + 3]), "v"(A[k]), "v"(B[k]));
    }
    R = E;
}
template <int NB, int KS, int CS, int VDH, int MODE  > __device__ __forceinline__ void tile(f32x16 (&o)[2], float& R, const bf16x8 (&qr)[4], lptr Ks, lptr Vs, float bias2, int lane, int lim) {
    const int r32 = lane & 31, hi = lane >> 5;
    f32x16 p[NB];
#pragma unroll
    for (int blk = 0; blk < NB; ++blk)
#pragma unroll
        for (int r = 0; r < 16; ++r) p[blk][r] = bias2;
    lptr kb = Ks + r32 * KS + hi * CS;
#pragma unroll
    for (int d0 = 0; d0 < 4; ++d0)
#pragma unroll
        for (int blk = 0; blk < NB; ++blk) p[blk] = __builtin_amdgcn_mfma_f32_32x32x16_bf16(*(const __attribute__((address_space(3))) bf16x8*)(kb + 2 * d0 * CS + 32 * blk * KS), qr[d0], p[blk], 0, 0, 0);
    weights<NB, MODE == 1>(p, R, hi, lim);
    lptr vp = Vs + ((lane >> 4) & 1) * 32 + (lane & 3) * 8 + (4 * hi + ((lane & 15) >> 2)) * 64;
#pragma unroll
    for (int blk = 0; blk < NB; ++blk)
#pragma unroll
        for (int s2 = 0; s2 < 2; ++s2) { const int s = 2 * blk + s2;
            const bf16x8 pa = pack8f(p[blk][8 * s2], p[blk][8 * s2 + 1], p[blk][8 * s2 + 2], p[blk][8 * s2 + 3], p[blk][8 * s2 + 4], p[blk][8 * s2 + 5], p[blk][8 * s2 + 6], p[blk][8 * s2 + 7]);
#pragma unroll
            for (int d0 = 0; d0 < 2; ++d0) { const s16x4 lo = vtr(vp + d0 * VDH + s * 1024), hh = vtr(vp + d0 * VDH + s * 1024 + 512);
                const bf16x8 vf = {lo[0], lo[1], lo[2], lo[3], hh[0], hh[1], hh[2], hh[3]};
                o[d0] = __builtin_amdgcn_mfma_f32_32x32x16_bf16(pa, vf, o[d0], 0, 0, 0); } }
}
__device__ __forceinline__ void qk2(f32x16 (&p)[2], const bf16x8 (&qr)[4], lptr Ks, float bias2, int lane) {
    const int r32 = lane & 31, hi = lane >> 5;
#pragma unroll
    for (int blk = 0; blk < 2; ++blk)
#pragma unroll
        for (int r = 0; r < 16; ++r) p[blk][r] = bias2;
    lptr kb = Ks + r32 * 16 + hi * 1024;
#pragma unroll
    for (int d0 = 0; d0 < 4; ++d0)
#pragma unroll
        for (int blk = 0; blk < 2; ++blk) p[blk] = __builtin_amdgcn_mfma_f32_32x32x16_bf16(*(const __attribute__((address_space(3))) bf16x8*)(kb + 2 * d0 * 1024 + 32 * blk * 16), qr[d0], p[blk], 0, 0, 0);
}
__device__ __forceinline__ void wpv2(f32x16 (&o)[2], float& R, f32x16 (&p)[2], lptr Vs, int lane) {
    const int hi = lane >> 5;
    weights<2, false>(p, R, hi, 64);
    lptr vp = Vs + ((lane >> 4) & 1) * 32 + (lane & 3) * 8 + (4 * hi + ((lane & 15) >> 2)) * 64;
#pragma unroll
    for (int blk = 0; blk < 2; ++blk)
#pragma unroll
        for (int s2 = 0; s2 < 2; ++s2) { const int s = 2 * blk + s2;
            const bf16x8 pa = pack8f(p[blk][8 * s2], p[blk][8 * s2 + 1], p[blk][8 * s2 + 2], p[blk][8 * s2 + 3], p[blk][8 * s2 + 4], p[blk][8 * s2 + 5], p[blk][8 * s2 + 6], p[blk][8 * s2 + 7]);
#pragma unroll
            for (int d0 = 0; d0 < 2; ++d0) { const s16x4 lo = vtr(vp + d0 * 4096 + s * 1024), hh = vtr(vp + d0 * 4096 + s * 1024 + 512);
                const bf16x8 vf = {lo[0], lo[1], lo[2], lo[3], hh[0], hh[1], hh[2], hh[3]};
                o[d0] = __builtin_amdgcn_mfma_f32_32x32x16_bf16(pa, vf, o[d0], 0, 0, 0); } }
}
#define SBA_WAITBAR() asm volatile("s_waitcnt vmcnt(0) lgkmcnt(0)\n\ts_barrier" ::: "memory")
__device__ __forceinline__ void prompt_unit(LAS unsigned char* L, const bf16* Qa, const bf16* Ka, const bf16* Va, bf16* Ocat, float bias2, int b, int h, int qb, int wid, int lane) {
    const int r32 = lane & 31, hi = lane >> 5, q0 = qb * 256, NT = 4 * qb + 4;
    const size_t rowb = (size_t)b * TP;
    const bf16* Kh = Ka + rowb * 512 + h * 64; const bf16* Vh = Va + rowb * 512 + h * 64;
    const bf16* ksrc = Kh + (size_t)lane * 512 + wid * 8;
    const bf16* vsrc = Vh + (size_t)(16 * (wid & 3) + (lane >> 2)) * 512 + (wid >> 2) * 32 + (lane & 3) * 8;
#define SBA_DMA1(kt, off) do { __builtin_amdgcn_global_load_lds((const unsigned*)(ksrc + (size_t)(kt) * 64 * 512), (LAS unsigned*)(L + L_K + (off) + wid * 1024), 16, 0, 0); \
                                __builtin_amdgcn_global_load_lds((const unsigned*)(vsrc + (size_t)(kt) * 64 * 512), (LAS unsigned*)(L + L_V + (off) + wid * 1024), 16, 0, 0); } while (0)
#define SBA_DMA(kp, slot) do { SBA_DMA1(2 * (kp) + 1, (slot) * 2 * SLOTB); SBA_DMA1(2 * (kp), (slot) * 2 * SLOTB + SLOTB); } while (0)
    int kp = NT / 2 - 1;
    SBA_DMA(kp, 0);
    bf16x8 qr[4];
    const bf16* Qw = Qa + (rowb + q0 + wid * 32 + r32) * 512 + h * 64 + hi * 8;
#pragma unroll
    for (int d0 = 0; d0 < 4; ++d0) qr[d0] = *(const bf16x8*)(Qw + d0 * 16);
    f32x16 o[2];
#pragma unroll
    for (int r = 0; r < 16; ++r) { o[0][r] = 0.f; o[1][r] = 0.f; }
    float R = 1.f;
    const int trel = wid * 32 + r32;
    SBA_WAITBAR();
    int slot = 0;
    for (; kp >= NT / 2 - 2; --kp) {
        if (kp > 0) SBA_DMA(kp - 1, slot ^ 1);
#pragma unroll
        for (int sub = 0; sub < 2; ++sub) { const int kt = 2 * kp + 1 - sub, k0rel = 64 * kt - q0;
            if (k0rel < wid * 32 + 31) tile<2, 16, 1024, 4096, 1>(o, R, qr, (lptr)(L + L_K + (slot * 2 + sub) * SLOTB), (lptr)(L + L_V + (slot * 2 + sub) * SLOTB), bias2, lane, trel - k0rel); }
        SBA_WAITBAR();
        slot ^= 1;
    }
    for (; kp >= 0; --kp) {
        if (kp > 0) SBA_DMA(kp - 1, slot ^ 1);
        { f32x16 pA[2], pB[2];
          qk2(pA, qr, (lptr)(L + L_K + slot * 2 * SLOTB), bias2, lane);
          qk2(pB, qr, (lptr)(L + L_K + (slot * 2 + 1) * SLOTB), bias2, lane);
          wpv2(o, R, pA, (lptr)(L + L_V + slot * 2 * SLOTB), lane);
          wpv2(o, R, pB, (lptr)(L + L_V + (slot * 2 + 1) * SLOTB), lane); }
        SBA_WAITBAR();
        slot ^= 1;
    }
    LAS bf16* stg = (LAS bf16*)(L + L_STG + wid * 4096);
#pragma unroll
    for (int r = 0; r < 16; ++r) { const int orow = (r & 3) + 8 * (r >> 2) + 4 * hi;
        stg[orow * 64 + r32] = (bf16)(pg8::cvt_pk_bf16(o[0][r], 0.f) & 0xffffu); stg[orow * 64 + 32 + r32] = (bf16)(pg8::cvt_pk_bf16(o[1][r], 0.f) & 0xffffu); }
    asm volatile("s_waitcnt lgkmcnt(0)" ::: "memory");
    bf16* Ow = Ocat + (rowb + q0 + wid * 32) * DM + h * 64;
#pragma unroll
    for (int i = 0; i < 4; ++i) { const int row = i * 8 + (lane >> 3), ch = lane & 7; *(v4u*)(Ow + (size_t)row * DM + ch * 8) = *(const LAS v4u*)(stg + row * 64 + ch * 8); }
    asm volatile("s_waitcnt lgkmcnt(0)\n\ts_barrier" ::: "memory");
#undef SBA_DMA
#undef SBA_DMA1
}

constexpr int SNC = 4, SCH = PAST / SNC;
__device__ __forceinline__ void sample_wave_unit(LAS unsigned char* Lw, const bf16* Qa, const float* cache_k, const float* cache_v, const int* page_table, const float* outp, float* PO, float* PR,
                                                 float bias2, int s, int h, int c, int lane) {
    const int r32 = lane & 31, hi = lane >> 5, key16 = lane >> 4, c16 = lane & 15;
    LAS unsigned char* Kimg = Lw; LAS unsigned char* Vimg = Lw + 4608;
    bf16x8 qr[4];
#pragma unroll
    for (int d0 = 0; d0 < 4; ++d0) { qr[d0] = (bf16x8){0, 0, 0, 0, 0, 0, 0, 0}; if (r32 < 4) qr[d0] = *(const bf16x8*)(Qa + ((size_t)MP + 4 * s + r32) * 512 + h * 64 + 16 * d0 + 8 * hi); }
    f32x16 o[2];
#pragma unroll
    for (int r = 0; r < 16; ++r) { o[0][r] = 0.f; o[1][r] = 0.f; }
    float R = 1.f;
    a4 kr[8], vr[8];
    const int kt_hi = (c * SCH + SCH) / 32 - 1, kt_lo = c * SCH / 32;
    const bool top = (c == SNC - 1);
#define SMP_LOAD(kt) do { if ((kt) > kt_hi) { const size_t off = ((size_t)4 * s + key16) * 512 + h * 64 + c16 * 4; kr[0] = *(const a4*)(outp + O_KS + off); vr[0] = *(const a4*)(outp + O_VS + off); \
            _Pragma("unroll") for (int i = 1; i < 8; ++i) { kr[i] = (a4){0.f, 0.f, 0.f, 0.f}; vr[i] = (a4){0.f, 0.f, 0.f, 0.f}; } } \
        else { const int key0 = 32 * (kt), pg = page_table[s * NPAGES + (key0 >> 7)]; const size_t off = (((size_t)pg * PAGE + (key0 & 127) + key16) * SBH + h) * 64 + c16 * 4; \
            _Pragma("unroll") for (int i = 0; i < 8; ++i) { kr[i] = __builtin_nontemporal_load((const a4*)(cache_k + off + (size_t)i * 4 * 512)); vr[i] = __builtin_nontemporal_load((const a4*)(cache_v + off + (size_t)i * 4 * 512));     } } } while (0)
    int kt = top ? kt_hi + 1 : kt_hi;
    SMP_LOAD(kt);
    for (; kt >= kt_lo; --kt) {
#pragma unroll
        for (int i = 0; i < 8; ++i) { const int key = 4 * i + key16;
            *(LAS unsigned long long*)(Kimg + key * 144 + c16 * 8) = gdn_pk4(kr[i][0], kr[i][1], kr[i][2], kr[i][3]);
            *(LAS unsigned long long*)(Vimg + (c16 >> 3) * 2048 + (key >> 3) * 512 + (key & 7) * 64 + (c16 & 7) * 8) = gdn_pk4(vr[i][0], vr[i][1], vr[i][2], vr[i][3]); }
        const bool isnew = kt > kt_hi;
        if (kt > kt_lo) SMP_LOAD(kt - 1);
        if (isnew) tile<1, 144, 16, 2048, 1>(o, R, qr, (lptr)Kimg, (lptr)Vimg, bias2, lane, r32);
        else tile<1, 144, 16, 2048, 0>(o, R, qr, (lptr)Kimg, (lptr)Vimg, bias2, lane, 32);
    }
#undef SMP_LOAD
    const size_t u = ((size_t)(s * SBH + h)) * SNC + c;
    if (hi == 0) {
#pragma unroll
        for (int r = 0; r < 4; ++r) { PO[u * 256 + r * 64 + r32] = o[0][r]; PO[u * 256 + r * 64 + 32 + r32] = o[1][r]; }
        if (r32 < 4) PR[u * 4 + r32] = R;
    }
}
}

__device__ __forceinline__ void attn_sample_naive(Frame& F, int sq) {
    const bf16* Qa = WSP(bf16, WS_QA); bf16* Ocat = WSP(bf16, WS_OCAT);
    LAS float* Ks = (LAS float*)(F.lds + RING_OFF); LAS float* Vs = Ks + 8192;
    const int tid = F.tid;
    {
        const int h = (tid >> 2) & 7, j = tid & 3; const size_t row = (size_t)MP + sq * 4 + j;
        const float bias2 = F.sb_bias[h] * LOG2E;
        float q[64], o[64];
#pragma unroll
        for (int d = 0; d < 64; d += 8) { a4 v0, v1; unpack8(*(const v4u*)(Qa + row * 512 + h * 64 + d), v0, v1);
#pragma unroll
            for (int e = 0; e < 4; ++e) { q[d + e] = v0[e]; q[d + 4 + e] = v1[e]; } }
#pragma unroll
        for (int d = 0; d < 64; ++d) o[d] = 0.f;
        float prod = 1.f;
        for (int kt = 128; kt >= 0; --kt) {
            __syncthreads();
#pragma unroll
            for (int i = 0; i < 4; ++i) { const int f = tid + i * 512, r = f >> 7, c4 = (f & 127) * 4;
                const float *kp, *vp; bool ok = true;
                if (kt == 128) { ok = r < 4; kp = F.out + O_KS + (size_t)(sq * 4 + (r & 3)) * 512 + c4; vp = F.out + O_VS + (size_t)(sq * 4 + (r & 3)) * 512 + c4; }
                else { const int key = kt * 16 + r, pg = F.page_table[sq * NPAGES + (key >> 7)]; const size_t off = ((size_t)pg * PAGE + (key & 127)) * 512 + c4; kp = F.cache_k + off; vp = F.cache_v + off; }
                if (ok) { *(LAS a4*)(Ks + r * 512 + c4) = *(const a4*)kp; *(LAS a4*)(Vs + r * 512 + c4) = *(const a4*)vp; } }
            __syncthreads();
            if (tid < 32) {
                for (int s = (kt == 128 ? 3 : 15); s >= 0; --s) {
                    const bool valid = (kt < 128) || (s < j);
                    float z = bias2;
#pragma unroll
                    for (int d = 0; d < 64; d += 4) { const a4 kv = *(const LAS a4*)(Ks + s * 512 + h * 64 + d); z += q[d] * kv[0] + q[d + 1] * kv[1] + q[d + 2] * kv[2] + q[d + 3] * kv[3]; }
                    const float e = __builtin_amdgcn_exp2f(z), r = __builtin_amdgcn_rcpf(1.f + e);
                    const float w = valid ? e * r * prod : 0.f;
                    if (valid) prod *= r;
#pragma unroll
                    for (int d = 0; d < 64; d += 4) { const a4 vv = *(const LAS a4*)(Vs + s * 512 + h * 64 + d); o[d] += w * vv[0]; o[d + 1] += w * vv[1]; o[d + 2] += w * vv[2]; o[d + 3] += w * vv[3]; }
                }
            }
        }
        if (tid < 32) {
#pragma unroll
            for (int d = 0; d < 64; d += 8) { a4 v0 = {o[d], o[d + 1], o[d + 2], o[d + 3]}, v1 = {o[d + 4], o[d + 5], o[d + 6], o[d + 7]}; *(v4u*)(Ocat + row * DM + h * 64 + d) = pack8(v0, v1); }
        }
    }
    __syncthreads();
}
constexpr int CW_Q3 = 2048;
__device__ __forceinline__ void gdn_naive_unit(Frame& F, int un) {
    const float* QKVN = WSP(float, WS_QKVN); const float* GBETA = WSP(float, WS_GBETA); float* ORAW = WSP(float, WS_ORAW);
    LAS float* Ls = (LAS float*)(F.lds + RING_OFF);
    const int tid = F.tid, c = tid >> 2, rq = tid & 3;
    {
        const bool prompt = un < NBP * GH; int seq, h, T; size_t row0; const float* s0; float* sout;
        if (prompt) { seq = un / GH; h = un % GH; T = TP; row0 = (size_t)seq * TP; s0 = nullptr; sout = F.out + O_SP + (size_t)(seq * GH + h) * GD * GD; }
        else { const int v = un - NBP * GH; seq = v / GH; h = v % GH; T = TS; row0 = (size_t)MP + seq * TS; s0 = F.state_ssm + (size_t)(seq * GH + h) * GD * GD; sout = F.out + O_SS + (size_t)(seq * GH + h) * GD * GD; }
        float S[32];
#pragma unroll
        for (int i = 0; i < 32; ++i) S[i] = 0.f;
    if (s0) {
#pragma unroll
        for (int i = 0; i < 32; ++i) S[i] = __builtin_nontemporal_load((const GAS float*)s0 + (size_t)(rq * 32 + i) * GD + c); }
        for (int t0 = 0; t0 < T; t0 += 16) {
            const int nt = (T - t0) < 16 ? (T - t0) : 16;
            __syncthreads();
            for (int f = tid; f < nt * 96; f += NTHR) { const int r = f / 96, q4 = f % 96, part = q4 / 32, c4 = (q4 % 32) * 4;
                *(LAS a4*)(Ls + r * 384 + part * 128 + c4) = *(const a4*)(QKVN + (row0 + t0 + r) * CONVD + part * 512 + h * 128 + c4); }
            if (tid < nt) { Ls[6144 + 2 * tid] = GBETA[(row0 + t0 + tid) * 8 + h]; Ls[6144 + 2 * tid + 1] = GBETA[(row0 + t0 + tid) * 8 + 4 + h]; }
            __syncthreads();
            for (int r = 0; r < nt; ++r) {
                const LAS float* qv = Ls + r * 384 + rq * 32; const LAS float* kv = qv + 128; const float vv = Ls[r * 384 + 256 + c];
                const float eg = __expf(Ls[6144 + 2 * r]), beta = Ls[6144 + 2 * r + 1];
                float kk[32]; float ks = 0.f;
#pragma unroll
                for (int i = 0; i < 32; i += 4) { const a4 k4 = *(const LAS a4*)(kv + i); kk[i] = k4[0]; kk[i + 1] = k4[1]; kk[i + 2] = k4[2]; kk[i + 3] = k4[3]; }
#pragma unroll
                for (int i = 0; i < 32; ++i) ks += kk[i] * S[i];
                ks += __shfl_xor(ks, 1); ks += __shfl_xor(ks, 2);
                const float vn = beta * (vv - eg * ks);
                float os = 0.f;
#pragma unroll
                for (int i = 0; i < 32; i += 4) { const a4 q4 = *(const LAS a4*)(qv + i);
#pragma unroll
                    for (int e = 0; e < 4; ++e) { S[i + e] = eg * S[i + e] + kk[i + e] * vn; os += q4[e] * S[i + e]; } }
                os += __shfl_xor(os, 1); os += __shfl_xor(os, 2);
                if (rq == 0) ORAW[(row0 + t0 + r) * GDIM + h * 128 + c] = os;
            }
        }
#pragma unroll
        for (int i = 0; i < 32; ++i) __builtin_nontemporal_store(S[i], sout + (size_t)(rq * 32 + i) * GD + c);
    }
    __syncthreads();
}


namespace gdn {
typedef float f32x16 __attribute__((ext_vector_type(16)));
typedef short s16x4 __attribute__((ext_vector_type(4)));
typedef __attribute__((address_space(3))) const unsigned char* lptr;
constexpr int NCH = TP / 64;
constexpr int REC_W = 0, REC_Q = 16384, REC_K = 32768, REC_P = 49152, REC_BYTES = 57344;
constexpr int UT_FLOATS = 128 * 64;
constexpr int P_KB = 0, P_QB = 17408, P_SC = 34816, P_MM = 35840, P_PB = 53248, P_AB = 62464, P_RH = 71680, P_VB = 104448, P_END = 121856;
constexpr int S_W = 0, S_Q = 17408, S_K = 34816, S_P = 53248, S_U = 62464, S_EG = 71680, S_BUF = 71744;

__device__ __forceinline__ bf16x8 ld2x8(lptr p, int second) {
    const s16x4 a = *(const __attribute__((address_space(3))) s16x4*)p, b = *(const __attribute__((address_space(3))) s16x4*)(p + second);
    return (bf16x8){a[0], a[1], a[2], a[3], b[0], b[1], b[2], b[3]};
}
__device__ __forceinline__ unsigned long long pk4(float a, float b, float c, float d) { return (unsigned long long)pg8::cvt_pk_bf16(a, b) | ((unsigned long long)pg8::cvt_pk_bf16(c, d) << 32); }

__device__ __forceinline__ int kpos(int c) { const int x = c & 31; return (c & ~31) + 8 * ((x >> 2) & 3) + 4 * (x >> 4) + (x & 3); }
__device__ __forceinline__ void prep_unit(Frame& F, int unit) {
    const int tid = F.tid, lane = F.lane, wid = F.wave, r32 = lane & 31, hi = lane >> 5;
    const int bh = unit / NCH, n = unit % NCH, b = bh / GH, h = bh % GH;
    const size_t row0 = (size_t)b * TP + (size_t)n * 64;
    const float* QKVN = WSP(float, WS_QKVN); const float* GBETA = WSP(float, WS_GBETA);
    const float* qg = QKVN + row0 * CONVD + h * 128; const float* kg = qg + 512; const float* vg = qg + 1024;
    unsigned char* rec = WSP(unsigned char, WS_GREC) + (size_t)unit * REC_BYTES; bf16* UT = WSP(bf16, WS_GUT) + (size_t)unit * UT_FLOATS;
    LAS unsigned char* L = F.lds + RING_OFF;
    LAS float* SC = (LAS float*)(L + P_SC);
    LAS float* MM = (LAS float*)(L + P_MM);
    conv_rows8(F, row0 + 8 * wid, n * 64 + 8 * wid, b, h, lane, L, SC, 8 * wid);
    __syncthreads();
    if (wid == 0) {
        float cg = SC[lane];
#pragma unroll
        for (int o = 1; o < 64; o <<= 1) { const float t = __shfl_up(cg, o); if (lane >= o) cg += t; }
        const float cgl = __shfl(cg, 63);
        SC[lane] = cg; SC[128 + lane] = __expf(cg); SC[192 + lane] = __expf(cgl - cg);
        if (lane == 0) WSP(float, WS_GEG)[unit] = __expf(cgl);
    }
    __syncthreads();
    {
        const int rt = (wid >> 1) & 1, ct = wid & 1; const bool isq = wid >= 4;
        f32x16 acc;
#pragma unroll
        for (int r = 0; r < 16; ++r) acc[r] = 0.f;
        lptr ap = (lptr)(L + (isq ? P_QB : P_KB) + (32 * rt + r32) * 272 + hi * 16), bp = (lptr)(L + P_KB + (32 * ct + r32) * 272 + hi * 16);
#pragma unroll
        for (int s = 0; s < 8; ++s) acc = __builtin_amdgcn_mfma_f32_32x32x16_bf16(*(const __attribute__((address_space(3))) bf16x8*)(ap + s * 32), *(const __attribute__((address_space(3))) bf16x8*)(bp + s * 32), acc, 0, 0, 0);
        const int j = 32 * ct + r32; const float cgj = SC[j];
#pragma unroll
        for (int r = 0; r < 16; ++r) { const int i = 32 * rt + (r & 3) + 8 * (r >> 2) + 4 * hi;
            const float dec = __expf(fminf(SC[i] - cgj, 0.f));
            if (!isq) MM[i * 68 + j] = (i > j) ? SC[64 + i] * acc[r] * dec : 0.f;
            else *(LAS bf16*)(L + P_PB + i * 144 + kpos(j) * 2) = (bf16)(pg8::cvt_pk_bf16((i >= j) ? acc[r] * dec : 0.f, 0.f) & 0xffffu); }
    }
#pragma unroll
    for (int i = 0; i < 8; ++i) { const int f = tid + i * 512, c = f >> 6, col = (f & 63) * 4;
        const float sc = (col < 128) ? SC[64 + c] * SC[128 + c] : SC[64 + c];
        const unsigned long long x = *(const LAS unsigned long long*)(L + (col < 128 ? P_KB + c * 272 + col * 2 : P_VB + c * 272 + (col - 128) * 2));
        *(LAS unsigned long long*)(L + P_RH + (col >> 5) * 4096 + (c >> 3) * 512 + (c & 7) * 64 + (col & 31) * 2) =
            pk4(__uint_as_float((unsigned)x << 16) * sc, __uint_as_float((unsigned)x & 0xffff0000u) * sc, __uint_as_float((unsigned)(x >> 32) << 16) * sc, __uint_as_float((unsigned)(x >> 32) & 0xffff0000u) * sc); }
    __syncthreads();
    if (wid == 0) {
        float t[64];
#pragma unroll
        for (int i = 0; i < 64; ++i) {
            float a0 = (i == lane) ? 1.f : 0.f, a1 = 0.f, a2 = 0.f, a3 = 0.f;
#pragma unroll
            for (int j = 0; j < i; j += 4) { const a4 m = *(const LAS a4*)(MM + i * 68 + j);
                a0 -= m[0] * t[j]; if (j + 1 < i) a1 -= m[1] * t[j + 1]; if (j + 2 < i) a2 -= m[2] * t[j + 2]; if (j + 3 < i) a3 -= m[3] * t[j + 3]; }
            t[i] = (a0 + a1) + (a2 + a3);
            *(LAS bf16*)(L + P_AB + i * 144 + lane * 2) = (bf16)(pg8::cvt_pk_bf16(t[i], 0.f) & 0xffffu);
        }
    } else {
        const int t7 = tid - 64;
        for (int f = t7; f < 1024; f += 448) { const int row = f >> 4, c8 = (f & 15) * 8; const float e = SC[128 + row];
            a4 x0, x1; unpack8(*(const LAS v4u*)(L + P_QB + row * 272 + c8 * 2), x0, x1);
            *(unsigned long long*)(rec + REC_Q + row * 256 + kpos(c8) * 2) = pk4(x0[0] * e, x0[1] * e, x0[2] * e, x0[3] * e); *(unsigned long long*)(rec + REC_Q + row * 256 + kpos(c8 + 4) * 2) = pk4(x1[0] * e, x1[1] * e, x1[2] * e, x1[3] * e); }
        for (int f = t7; f < 1024; f += 448) { const int dk = f & 127, c8 = (f >> 7) * 8; float x[8];
#pragma unroll
            for (int e = 0; e < 8; ++e) x[e] = bf2f(*(const LAS bf16*)(L + P_KB + (c8 + e) * 272 + dk * 2)) * SC[192 + c8 + e];
            *(unsigned long long*)(rec + REC_K + dk * 128 + kpos(c8) * 2) = pk4(x[0], x[1], x[2], x[3]); *(unsigned long long*)(rec + REC_K + dk * 128 + kpos(c8 + 4) * 2) = pk4(x[4], x[5], x[6], x[7]); }
        for (int f = t7; f < 512; f += 448) { const int row = f >> 3, ch = f & 7; *(v4u*)(rec + REC_P + row * 128 + ch * 16) = *(const LAS v4u*)(L + P_PB + row * 144 + ch * 16); }
    }
    __syncthreads();
    {
        const int cb = wid;
        lptr vp = (lptr)(L + P_RH + cb * 4096) + ((lane >> 4) & 1) * 32 + (lane & 3) * 8 + (4 * hi + ((lane & 15) >> 2)) * 64;
        bf16x8 rf[4];
#pragma unroll
        for (int s = 0; s < 4; ++s) { const s16x4 lo = sba::vtr(vp + s * 1024), hh = sba::vtr(vp + s * 1024 + 512); rf[s] = (bf16x8){lo[0], lo[1], lo[2], lo[3], hh[0], hh[1], hh[2], hh[3]}; }
#pragma unroll
        for (int rt = 0; rt < 2; ++rt) {
            f32x16 acc;
#pragma unroll
            for (int r = 0; r < 16; ++r) acc[r] = 0.f;
            lptr ap = (lptr)(L + P_AB + (32 * rt + r32) * 144 + hi * 8);
#pragma unroll
            for (int s = 0; s < 4; ++s) { const bf16x8 af = ld2x8(ap + s * 32, 16);
                acc = (cb < 4) ? __builtin_amdgcn_mfma_f32_32x32x16_bf16(rf[s], af, acc, 0, 0, 0) : __builtin_amdgcn_mfma_f32_32x32x16_bf16(af, rf[s], acc, 0, 0, 0); }
            if (cb < 4) { const int c = 32 * rt + r32;
#pragma unroll
                for (int g = 0; g < 4; ++g) *(unsigned long long*)(rec + REC_W + c * 256 + kpos(32 * cb + 8 * g + 4 * hi) * 2) = pk4(acc[4 * g], acc[4 * g + 1], acc[4 * g + 2], acc[4 * g + 3]);
            } else { const int dv = 32 * (cb - 4) + r32;
#pragma unroll
                for (int g = 0; g < 4; ++g) *(unsigned long long*)(UT + dv * 64 + 32 * rt + 8 * g + 4 * hi) = pk4(acc[4 * g], acc[4 * g + 1], acc[4 * g + 2], acc[4 * g + 3]); }
        }
    }
    __syncthreads();
}

__device__ __forceinline__ void scan_task(Frame& F, int bh, int half) {
    const int tid = F.tid, lane = F.lane, wid = F.wave, col = lane & 15, q4 = lane >> 4, b = bh / GH, h = bh % GH, dv = 64 * half + 16 * (wid & 3) + col;
    const bool cw = wid < 4;
    const unsigned char* rec = WSP(unsigned char, WS_GREC) + (size_t)bh * NCH * REC_BYTES;
    const bf16* UT = WSP(bf16, WS_GUT) + (size_t)bh * NCH * UT_FLOATS + (size_t)64 * half * 64; const float* EG = WSP(float, WS_GEG) + bh * NCH;
    float* ORAW = WSP(float, WS_ORAW);
    LAS unsigned char* L = F.lds + RING_OFF;
    if (!cw) {
        const int lt = tid - 256;
        int ldso[16];
#pragma unroll
        for (int i = 0; i < 14; ++i) { const int p = lt + 256 * i;
            ldso[i] = p < 1024 ? S_W + (p >> 4) * 272 + (p & 15) * 16 : p < 2048 ? S_Q + ((p - 1024) >> 4) * 272 + (p & 15) * 16
                    : p < 3072 ? S_K + ((p - 2048) >> 3) * 144 + (p & 7) * 16 : S_P + ((p - 3072) >> 3) * 144 + (p & 7) * 16; }
#pragma unroll
        for (int i = 14; i < 16; ++i) { const int p = lt + 256 * (i - 14); ldso[i] = S_U + (p >> 3) * 144 + (p & 7) * 16; }
        v4u sa[16], sb[16]; float ea = 0.f, eb = 0.f;
#define SC_ISSUE(set, eg_, n_) do { _Pragma("unroll") for (int i = 0; i < 14; ++i) set[i] = *(const GAS v4u*)(rec + (size_t)(n_) * REC_BYTES + (size_t)(lt + 256 * i) * 16); \
        _Pragma("unroll") for (int i = 14; i < 16; ++i) set[i] = *(const GAS v4u*)((const unsigned char*)(UT + (size_t)(n_) * UT_FLOATS) + (size_t)(lt + 256 * (i - 14)) * 16); \
        eg_ = EG[n_]; } while (0)
#define SC_WRITE(set, eg_, buf) do { LAS unsigned char* Bw = L + (buf) * S_BUF; _Pragma("unroll") for (int i = 0; i < 16; ++i) *(LAS v4u*)(Bw + ldso[i]) = set[i]; \
        if (lt == 0) *(LAS float*)(Bw + S_EG) = eg_; } while (0)
        SC_ISSUE(sa, ea, 0); SC_ISSUE(sb, eb, 1);
        SC_WRITE(sa, ea, 0);
        __syncthreads();
        for (int n = 0; n < NCH; n += 2) {
            if (n + 2 < NCH) SC_ISSUE(sa, ea, n + 2);
            SC_WRITE(sb, eb, 1);
            __syncthreads();
            if (n + 3 < NCH) SC_ISSUE(sb, eb, n + 3);
            if (n + 2 < NCH) SC_WRITE(sa, ea, 0);
            __syncthreads();
        }
#undef SC_ISSUE
#undef SC_WRITE
        return;
    }
    a4 S[8];
#pragma unroll
    for (int t = 0; t < 8; ++t) S[t] = (a4){0.f, 0.f, 0.f, 0.f};
    __syncthreads();
    for (int n = 0; n < NCH; ++n) {
        LAS unsigned char* B = L + (n & 1) * S_BUF;
        unsigned long long u[4];
#pragma unroll
        for (int r = 0; r < 4; ++r) u[r] = *(const LAS unsigned long long*)(B + S_U + (16 * (wid & 3) + col) * 144 + (16 * r + 4 * q4) * 2);
        const float eg = *(const LAS float*)(B + S_EG);
        {
        bf16x8 Sb[4];
#pragma unroll
        for (int s = 0; s < 4; ++s) Sb[s] = sba::pack8f(S[2 * s][0], S[2 * s][1], S[2 * s][2], S[2 * s][3], S[2 * s + 1][0], S[2 * s + 1][1], S[2 * s + 1][2], S[2 * s + 1][3]);
        lptr wq = (lptr)(B + S_W + col * 272 + q4 * 16), qq = (lptr)(B + S_Q + col * 272 + q4 * 16), kq = (lptr)(B + S_K + col * 144 + q4 * 16), pq = (lptr)(B + S_P + col * 144 + q4 * 16);
#define GF(p) (*(const __attribute__((address_space(3))) bf16x8*)(p))
#define SBR() __builtin_amdgcn_sched_barrier(0)
#define UF(x) ((a4){__uint_as_float((unsigned)(x) << 16), __uint_as_float((unsigned)(x) & 0xffff0000u), __uint_as_float((unsigned)((x) >> 32) << 16), __uint_as_float((unsigned)((x) >> 32) & 0xffff0000u)})
        bf16x8 fa[8], fb[8];
        a4 vn[4], o[4];
#pragma unroll
        for (int i = 0; i < 8; ++i) fa[i] = GF(wq + (i >> 2) * 16 * 272 + (i & 3) * 64);
        SBR();
#pragma unroll
        for (int i = 0; i < 8; ++i) fb[i] = GF(wq + (2 + (i >> 2)) * 16 * 272 + (i & 3) * 64);
        SBR();
#pragma unroll
        for (int r = 0; r < 2; ++r) { a4 acc = {0.f, 0.f, 0.f, 0.f};
#pragma unroll
            for (int s = 0; s < 4; ++s) acc = __builtin_amdgcn_mfma_f32_16x16x32_bf16(fa[4 * r + s], Sb[s], acc, 0, 0, 0);
            vn[r] = UF(u[r]) - acc; }
        SBR();
#pragma unroll
        for (int i = 0; i < 8; ++i) fa[i] = GF(qq + (i >> 2) * 16 * 272 + (i & 3) * 64);
        SBR();
#pragma unroll
        for (int r = 0; r < 2; ++r) { a4 acc = {0.f, 0.f, 0.f, 0.f};
#pragma unroll
            for (int s = 0; s < 4; ++s) acc = __builtin_amdgcn_mfma_f32_16x16x32_bf16(fb[4 * r + s], Sb[s], acc, 0, 0, 0);
            vn[2 + r] = UF(u[2 + r]) - acc; }
        SBR();
#pragma unroll
        for (int i = 0; i < 8; ++i) fb[i] = GF(qq + (2 + (i >> 2)) * 16 * 272 + (i & 3) * 64);
        SBR();
#pragma unroll
        for (int r = 0; r < 2; ++r) { a4 acc = {0.f, 0.f, 0.f, 0.f};
#pragma unroll
            for (int s = 0; s < 4; ++s) acc = __builtin_amdgcn_mfma_f32_16x16x32_bf16(fa[4 * r + s], Sb[s], acc, 0, 0, 0);
            o[r] = acc; }
        bf16x8 vb[2];
#pragma unroll
        for (int s = 0; s < 2; ++s) vb[s] = sba::pack8f(vn[2 * s][0], vn[2 * s][1], vn[2 * s][2], vn[2 * s][3], vn[2 * s + 1][0], vn[2 * s + 1][1], vn[2 * s + 1][2], vn[2 * s + 1][3]);
        SBR();
#pragma unroll
        for (int i = 0; i < 8; ++i) fa[i] = GF(kq + (i >> 1) * 16 * 144 + (i & 1) * 64);
        SBR();
#pragma unroll
        for (int r = 0; r < 2; ++r) { a4 acc = {0.f, 0.f, 0.f, 0.f};
#pragma unroll
            for (int s = 0; s < 4; ++s) acc = __builtin_amdgcn_mfma_f32_16x16x32_bf16(fb[4 * r + s], Sb[s], acc, 0, 0, 0);
            o[2 + r] = acc; }
        SBR();
#pragma unroll
        for (int i = 0; i < 8; ++i) fb[i] = GF(kq + (4 + (i >> 1)) * 16 * 144 + (i & 1) * 64);
        SBR();
#pragma unroll
        for (int t = 0; t < 4; ++t) { a4 acc = S[t] * eg;
#pragma unroll
            for (int s = 0; s < 2; ++s) acc = __builtin_amdgcn_mfma_f32_16x16x32_bf16(fa[2 * t + s], vb[s], acc, 0, 0, 0);
            S[t] = acc; }
        SBR();
#pragma unroll
        for (int i = 0; i < 8; ++i) fa[i] = GF(pq + (i >> 1) * 16 * 144 + (i & 1) * 64);
        SBR();
#pragma unroll
        for (int t = 0; t < 4; ++t) { a4 acc = S[4 + t] * eg;
#pragma unroll
            for (int s = 0; s < 2; ++s) acc = __builtin_amdgcn_mfma_f32_16x16x32_bf16(fb[2 * t + s], vb[s], acc, 0, 0, 0);
            S[4 + t] = acc; }
        SBR();
#pragma unroll
        for (int r = 0; r < 4; ++r) {
#pragma unroll
            for (int s = 0; s < 2; ++s) o[r] = __builtin_amdgcn_mfma_f32_16x16x32_bf16(fa[2 * r + s], vb[s], o[r], 0, 0, 0);
        }
#undef GF
#undef SBR
#undef UF
        float* op = ORAW + ((size_t)b * TP + (size_t)n * 64 + 4 * q4) * GDIM + h * 128 + dv;
#pragma unroll
        for (int r = 0; r < 4; ++r)
#pragma unroll
            for (int e = 0; e < 4; ++e) op[(size_t)(16 * r + e) * GDIM] = o[r][e];
        }
        __syncthreads();
    }
    float* sout = F.out + O_SP + (size_t)bh * GD * GD + dv;
#pragma unroll
    for (int t = 0; t < 8; ++t)
#pragma unroll
        for (int e = 0; e < 4; ++e) sout[(size_t)(16 * t + 4 * q4 + e) * GD] = S[t][e];
}
}


__device__ __forceinline__ void p4_mixers(Frame& F, int qoff, unsigned long long& ts_a, unsigned long long& ts_b) {
    constexpr int NSC = NBP * GH, NPU = NBP * SBH * (TP / 256), NSU = NBS * sba::SNC;
    volatile LAS int* qs = (volatile LAS int*)(F.lds + LDSCTL_OFF + 64);
    if (F.vcu % 16 == 0 && F.vcu / 32 < NSC) gdn::scan_task(F, F.vcu / 32, (F.vcu >> 4) & 1);
    else if (F.vcu % 3 == 1) {
        for (;;) {
            __syncthreads();
            if (F.tid == 0) *qs = (int)__hip_atomic_fetch_add((unsigned*)(F.ctl + CW_Q3 + 64 + qoff), 1u, __ATOMIC_RELAXED, __HIP_MEMORY_SCOPE_AGENT);
            __syncthreads();
            const int u = __builtin_amdgcn_readfirstlane(*qs);
            if (u >= NSU) break;
            const int sq = u / sba::SNC, c = (sba::SNC - 1) - (u % sba::SNC), h = F.wave;
            sba::sample_wave_unit(F.lds + RING_OFF + F.wave * 8704, WSP(bf16, WS_QA), F.cache_k, F.cache_v, F.page_table, F.out, WSP(float, WS_SPO), WSP(float, WS_SPR), F.sb_bias[h] * LOG2E, sq, h, c, F.lane);
        }
    }
    if (PROBE_WAIT_PHASE >= 100 && PROBE_WAIT_PHASE < 200) ts_a = __builtin_amdgcn_s_memrealtime();
    for (;;) {
        __syncthreads();
        if (F.tid == 0) *qs = (int)__hip_atomic_fetch_add((unsigned*)(F.ctl + CW_Q3 + qoff), 1u, __ATOMIC_RELAXED, __HIP_MEMORY_SCOPE_AGENT);
        __syncthreads();
        const int u = __builtin_amdgcn_readfirstlane(*qs);
        if (u >= NPU + NBS * GH) break;
        if (u >= NPU) { gdn_naive_unit(F, NBP * GH + (u - NPU)); continue; }
        const int qb = (TP / 256 - 1) - u / (NBP * SBH), bh = u % (NBP * SBH), b = bh / SBH, h = bh % SBH;
        sba::prompt_unit(F.lds + RING_OFF, WSP(bf16, WS_QA), WSP(bf16, WS_KA), WSP(bf16, WS_VA), WSP(bf16, WS_OCAT), F.sb_bias[h] * LOG2E, b, h, qb, F.wave, F.lane);
    }
    if (PROBE_WAIT_PHASE >= 100 && PROBE_WAIT_PHASE < 200) ts_b = __builtin_amdgcn_s_memrealtime();
}
__device__ __forceinline__ void p5_sample_naive(Frame& F) {
    for (int un = F.vcu; un < NBS * GH; un += F.G) gdn_naive_unit(F, NBP * GH + un);
}
__device__ __forceinline__ void p3_gdn_prep(Frame& F, unsigned long long& ts0, unsigned long long& ts1, unsigned long long& ts2) {
    if (PROBE_WAIT_PHASE >= 300) ts0 = __builtin_amdgcn_s_memrealtime();
    int cnt = 0;
    for (int u = F.vcu; u < NBP * GH * gdn::NCH; u += F.G) { gdn::prep_unit(F, u); ++cnt;
        if (PROBE_WAIT_PHASE >= 300 && cnt == 1) ts1 = __builtin_amdgcn_s_memrealtime();
        if (PROBE_WAIT_PHASE >= 300 && cnt == 2) ts2 = __builtin_amdgcn_s_memrealtime(); }
    p2_gdn_prep(F); }
__device__ __forceinline__ void p5_gdn_post(Frame& F) {
    const int gw = F.vcu * NWAVES + F.wave, NGW = F.G * NWAVES, lane = F.lane;
    {
        const float* PO = WSP(float, WS_SPO); const float* PR = WSP(float, WS_SPR); bf16* Oc = WSP(bf16, WS_OCAT);
        for (int it = gw; it < NBS * SBH * TS; it += NGW) { const int j = it & 3, sh = it >> 2, sq = sh >> 3, h = sh & 7;
            float acc = 0.f, wgt = 1.f;
#pragma unroll
            for (int c = sba::SNC - 1; c >= 0; --c) { const size_t u = (size_t)sh * sba::SNC + c; acc += wgt * PO[u * 256 + j * 64 + lane]; wgt *= PR[u * 4 + j]; }
            Oc[((size_t)MP + 4 * sq + j) * DM + h * 64 + lane] = (bf16)(pg8::cvt_pk_bf16(acc, 0.f) & 0xffffu); }
    }
    const float* ORAW = WSP(float, WS_ORAW); const bf16* Zb = WSP(bf16, WS_ZB); bf16* Ocat = WSP(bf16, WS_OCAT);
    for (int it = gw; it < M * GH; it += NGW) {
        const int row = it >> 2, h = it & 3; const size_t ix = (size_t)row * GDIM + h * 128 + 2 * lane;
        const float o0 = __builtin_nontemporal_load(ORAW + ix), o1 = __builtin_nontemporal_load(ORAW + ix + 1);
        const float rs = __builtin_amdgcn_rsqf(wave_sum(o0 * o0 + o1 * o1) * (1.f / GD) + NORM_EPS);
        const unsigned zz = *(const unsigned*)(Zb + ix); const float z0 = __uint_as_float(zz << 16), z1 = __uint_as_float(zz & 0xffff0000u);
        const float r0 = o0 * rs * F.gdn_norm_w[2 * lane] * (z0 * sigmoidf_(z0)), r1 = o1 * rs * F.gdn_norm_w[2 * lane + 1] * (z1 * sigmoidf_(z1));
        *(unsigned*)(Ocat + (size_t)row * DM + 512 + h * 128 + 2 * lane) = pk2(r0, r1);
    }
}

__device__ __forceinline__ void p10_final(Frame& F) {
    const int gw = F.vcu * NWAVES + F.wave, NGW = F.G * NWAVES, lane = F.lane;
    f32x4 nw[4];
#pragma unroll
    for (int j = 0; j < 4; ++j) nw[j] = *((const f32x4*)F.norm_final_w + lane + 64 * j);
    for (int m = gw; m < M; m += NGW) {
        GAS f32x4* yr = (GAS f32x4*)(F.out + O_Y + (size_t)m * DM) + lane;
        f32x4 v[4]; float s = 0.f;
#pragma unroll
        for (int j = 0; j < 4; ++j) { v[j] = yr[64 * j]; s += (v[j].x * v[j].x + v[j].y * v[j].y) + (v[j].z * v[j].z + v[j].w * v[j].w); }
        const float rs = 1.f / sqrtf(wave_sum(s) * (1.f / DM) + NORM_EPS);
#pragma unroll
        for (int j = 0; j < 4; ++j) yr[64 * j] = v[j] * rs * nw[j];
    }
}

namespace sg {
typedef float f32x16 __attribute__((ext_vector_type(16)));
__device__ __forceinline__ void tile(LAS unsigned char* L, const bf16* A, size_t lda, const bf16* Bt, size_t ldb, int K, int wid, int lane, int tid, a4& s0, a4& s1) {
    const int r32 = lane & 31, hi = lane >> 5, nj = K / 128;
    f32x16 acc0, acc1;
#pragma unroll
    for (int r = 0; r < 16; ++r) { acc0[r] = 0.f; acc1[r] = 0.f; }
    const int kb = (wid >> 2) * (K / 2) + (wid & 3) * 16 + 8 * hi;
    const bf16* ap = A + (size_t)r32 * lda + kb; const bf16* b0p = Bt + (size_t)r32 * ldb + kb; const bf16* b1p = b0p + 32 * ldb;
    for (int s = 0; s < nj; s += 8) {
        bf16x8 af[8], bf0[8], bf1[8];
#pragma unroll
        for (int i = 0; i < 8; ++i) { af[i] = *(const bf16x8*)(ap + (s + i) * 64); bf0[i] = *(const bf16x8*)(b0p + (s + i) * 64); bf1[i] = *(const bf16x8*)(b1p + (s + i) * 64); }
        __builtin_amdgcn_sched_barrier(0);
#pragma unroll
        for (int i = 0; i < 8; ++i) { acc0 = __builtin_amdgcn_mfma_f32_32x32x16_bf16(af[i], bf0[i], acc0, 0, 0, 0); acc1 = __builtin_amdgcn_mfma_f32_32x32x16_bf16(af[i], bf1[i], acc1, 0, 0, 0); }
        __builtin_amdgcn_sched_barrier(0);
    }
    LAS float* P = (LAS float*)L + wid * (32 * 68);
#pragma unroll
    for (int r = 0; r < 16; ++r) { const int row = (r & 3) + 8 * (r >> 2) + 4 * hi; P[row * 68 + r32] = acc0[r]; P[row * 68 + 32 + r32] = acc1[r]; }
    __syncthreads();
    const LAS float* Q = (const LAS float*)L + (tid >> 4) * 68 + (tid & 15) * 4;
    s0 = *(const LAS a4*)Q + *(const LAS a4*)(Q + 32 * 68) + *(const LAS a4*)(Q + 2 * 32 * 68) + *(const LAS a4*)(Q + 3 * 32 * 68);
    s1 = *(const LAS a4*)(Q + 4 * 32 * 68) + *(const LAS a4*)(Q + 5 * 32 * 68) + *(const LAS a4*)(Q + 6 * 32 * 68) + *(const LAS a4*)(Q + 7 * 32 * 68);
    __syncthreads();
}

__device__ __forceinline__ void tile2(LAS unsigned char* L, const bf16* A, size_t lda, const bf16* Bt, size_t ldb, int K, int wid, int lane, int tid, a4& lo, a4& hi_) {
    const int r32 = lane & 31, hi = lane >> 5, nj = K / 64;
    f32x16 acc0, acc1;
#pragma unroll
    for (int r = 0; r < 16; ++r) { acc0[r] = 0.f; acc1[r] = 0.f; }
    const int kb = (wid & 3) * 16 + 8 * hi;
    const bf16* ap = A + (size_t)r32 * lda + kb; const bf16* b0p = Bt + (size_t)((wid >> 2) * 64 + r32) * ldb + kb; const bf16* b1p = b0p + 32 * ldb;
    for (int s = 0; s < nj; s += 8) {
        bf16x8 af[8], bf0[8], bf1[8];
#pragma unroll
        for (int i = 0; i < 8; ++i) { af[i] = *(const bf16x8*)(ap + (s + i) * 64); bf0[i] = *(const bf16x8*)(b0p + (s + i) * 64); bf1[i] = *(const bf16x8*)(b1p + (s + i) * 64); }
        __builtin_amdgcn_sched_barrier(0);
#pragma unroll
        for (int i = 0; i < 8; ++i) { acc0 = __builtin_amdgcn_mfma_f32_32x32x16_bf16(af[i], bf0[i], acc0, 0, 0, 0); acc1 = __builtin_amdgcn_mfma_f32_32x32x16_bf16(af[i], bf1[i], acc1, 0, 0, 0); }
        __builtin_amdgcn_sched_barrier(0);
    }
    LAS float* P = (LAS float*)L + wid * (32 * 68);
#pragma unroll
    for (int r = 0; r < 16; ++r) { const int row = (r & 3) + 8 * (r >> 2) + 4 * hi; P[row * 68 + r32] = acc0[r]; P[row * 68 + 32 + r32] = acc1[r]; }
    __syncthreads();
    const LAS float* Q = (const LAS float*)L + (tid >> 4) * 68 + (tid & 15) * 4;
    lo = *(const LAS a4*)Q + *(const LAS a4*)(Q + 32 * 68) + *(const LAS a4*)(Q + 2 * 32 * 68) + *(const LAS a4*)(Q + 3 * 32 * 68);
    hi_ = *(const LAS a4*)(Q + 4 * 32 * 68) + *(const LAS a4*)(Q + 5 * 32 * 68) + *(const LAS a4*)(Q + 6 * 32 * 68) + *(const LAS a4*)(Q + 7 * 32 * 68);
    __syncthreads();
}
}
__device__ __forceinline__ void sample_merge(Frame& F) {
    for (int t = blockIdx.x; t < (MS / 32) * (DM / 64); t += F.G) { const int r0 = (t >> 4) * 32, c0 = (t & 15) * 64; a4 s0, s1;
        sg::tile(F.lds + RING_OFF, WSP(bf16, WS_OCAT) + (size_t)(MP + r0) * DM, DM, WSP(bf16, WS_WCAT) + (size_t)c0 * DM, DM, DM, F.wave, F.lane, F.tid, s0, s1);
        const size_t idx = (size_t)(MP + r0 + (F.tid >> 4)) * DM + c0 + (F.tid & 15) * 4;
        const unsigned long long ga = *(const unsigned long long*)(WSP(bf16, WS_GA) + idx), gb = *(const unsigned long long*)(WSP(bf16, WS_GB) + idx);
        const a4 a = {__uint_as_float((unsigned)ga << 16), __uint_as_float((unsigned)ga & 0xffff0000u), __uint_as_float((unsigned)(ga >> 32) << 16), __uint_as_float((unsigned)(ga >> 32) & 0xffff0000u)};
        const a4 b = {__uint_as_float((unsigned)gb << 16), __uint_as_float((unsigned)gb & 0xffff0000u), __uint_as_float((unsigned)(gb >> 32) << 16), __uint_as_float((unsigned)(gb >> 32) & 0xffff0000u)};
        const a4 m = a * s0 + b * s1;
        *(unsigned long long*)(WSP(bf16, WS_MB) + idx) = gdn_pk4(m[0], m[1], m[2], m[3]); }
}
__device__ __forceinline__ void sample_wo(Frame& F) {
    for (int t = blockIdx.x; t < (MS / 32) * (DM / 64); t += F.G) { const int r0 = (t >> 4) * 32, c0 = (t & 15) * 64; a4 s0, s1;
        sg::tile(F.lds + RING_OFF, WSP(bf16, WS_MB) + (size_t)(MP + r0) * DM, DM, WSP(bf16, WS_WO) + (size_t)c0 * DM, DM, DM, F.wave, F.lane, F.tid, s0, s1);
        const int rs = r0 + (F.tid >> 4), col = c0 + (F.tid & 15) * 4; const size_t idx = (size_t)(MP + rs) * DM + col;
        const a4 x1 = *(const a4*)(F.xs + (size_t)rs * DM + col) + s0 + s1;
        *(a4*)(WSP(float, WS_X1) + idx) = x1; *(unsigned long long*)(WSP(bf16, WS_X1B) + idx) = gdn_pk4(x1[0], x1[1], x1[2], x1[3]);
        float ss = (x1[0] * x1[0] + x1[1] * x1[1]) + (x1[2] * x1[2] + x1[3] * x1[3]);
        ss += __shfl_xor(ss, 1); ss += __shfl_xor(ss, 2); ss += __shfl_xor(ss, 4); ss += __shfl_xor(ss, 8);
        if ((F.tid & 15) == 0) __hip_atomic_fetch_add((float*)(F.ctl + CW_SS1) + MP + rs, ss, __ATOMIC_RELAXED, __HIP_MEMORY_SCOPE_AGENT); }
}
__device__ __forceinline__ void sample_up(Frame& F) {
    for (int t = blockIdx.x; t < (MS / 32) * (FF / 128); t += F.G) { const int r0 = (t >> 5) * 32, c0 = (t & 31) * 128; a4 lo, hi;
        const int rs = r0 + (F.tid >> 4), col = c0 + (F.tid & 15) * 4;
        const float ssq = __hip_atomic_load((const float*)(F.ctl + CW_SS1) + MP + rs, __ATOMIC_RELAXED, __HIP_MEMORY_SCOPE_AGENT);
        sg::tile2(F.lds + RING_OFF, WSP(bf16, WS_X1B) + (size_t)(MP + r0) * DM, DM, WSP(bf16, WS_WUP) + (size_t)c0 * DM, DM, DM, F.wave, F.lane, F.tid, lo, hi);
        const float rstd = __builtin_amdgcn_rsqf(ssq * (1.f / DM) + NORM_EPS);
        lo = lo * rstd; hi = hi * rstd;
#pragma unroll
        for (int e = 0; e < 4; ++e) { const float a = fmaxf(lo[e], 0.f), b = fmaxf(hi[e], 0.f); lo[e] = a * a; hi[e] = b * b; }
        bf16* hp = WSP(bf16, WS_H) + (size_t)(MP + rs) * FF + col;
        *(unsigned long long*)hp = gdn_pk4(lo[0], lo[1], lo[2], lo[3]); *(unsigned long long*)(hp + 64) = gdn_pk4(hi[0], hi[1], hi[2], hi[3]); }
}
__device__ __forceinline__ void sample_down(Frame& F, bool fuse) {
    for (int t = blockIdx.x; t < (MS / 32) * (DM / 64); t += F.G) { const int r0 = (t >> 4) * 32, c0 = (t & 15) * 64; a4 s0, s1;
        sg::tile(F.lds + RING_OFF, WSP(bf16, WS_H) + (size_t)(MP + r0) * FF, FF, WSP(bf16, WS_WDN) + (size_t)c0 * FF, FF, FF, F.wave, F.lane, F.tid, s0, s1);
        const int rs = r0 + (F.tid >> 4), col = c0 + (F.tid & 15) * 4; const size_t idx = (size_t)(MP + rs) * DM + col;
        a4 x2 = *(const a4*)(WSP(float, WS_X1) + idx) + s0 + s1;
        if (fuse) {
            float* SS = (float*)(F.ctl + CW_SS2); gu32* cnt = F.ctl + CW_PC + 64 * (64 + (t >> 4));
            float ss = (x2[0] * x2[0] + x2[1] * x2[1]) + (x2[2] * x2[2] + x2[3] * x2[3]);
            ss += __shfl_xor(ss, 1); ss += __shfl_xor(ss, 2); ss += __shfl_xor(ss, 4); ss += __shfl_xor(ss, 8);
            if ((F.tid & 15) == 0) __hip_atomic_fetch_add(SS + MP + rs, ss, __ATOMIC_RELAXED, __HIP_MEMORY_SCOPE_AGENT);
            asm volatile("s_waitcnt vmcnt(0)" ::: "memory");
            __syncthreads();
            if (F.tid == 0) { __hip_atomic_fetch_add(cnt, 1u, __ATOMIC_RELAXED, __HIP_MEMORY_SCOPE_AGENT); wait_count(cnt, 16u); }
            __syncthreads();
            const float r = 1.f / sqrtf(__hip_atomic_load(SS + MP + rs, __ATOMIC_RELAXED, __HIP_MEMORY_SCOPE_AGENT) * (1.f / DM) + NORM_EPS);
            x2 = x2 * r * *(const a4*)(F.norm_final_w + col);
        }
        *(a4*)(F.out + O_Y + idx) = x2; }
}
constexpr int N_PHASES = 12;
struct Args { const void* in[21]; float* out; unsigned char* ws; int ph_lo, ph_hi; };
__global__ void __launch_bounds__(NTHR, 2) mk_fwd(Args args) {
    extern __shared__ __attribute__((aligned(16))) unsigned char lds[];
    Frame F;
    F.lds = (LAS unsigned char*)lds; F.MISC = (volatile LAS unsigned*)(F.lds + MISC_OFF);
    F.tid = threadIdx.x; F.lane = F.tid & 63; F.wave = __builtin_amdgcn_readfirstlane(F.tid >> 6);
    F.G = gridDim.x; { const int bx = blockIdx.x; F.vcu = (F.G % 8 == 0) ? (bx % 8) * (F.G / 8) + bx / 8 : bx; }
    F.ws = args.ws; F.out = args.out; F.ctl = (gu32*)(args.ws + WS_CTL);
    F.xp = (const float*)args.in[0]; F.xs = (const float*)args.in[1]; F.cache_k = (const float*)args.in[2]; F.cache_v = (const float*)args.in[3]; F.page_table = (const int*)args.in[4];
    F.state_conv = (const float*)args.in[5]; F.state_ssm = (const float*)args.in[6]; F.norm_mix_w = (const float*)args.in[7]; F.w_in = (const float*)args.in[8]; F.sb_bias = (const float*)args.in[9];
    F.conv_w = (const float*)args.in[10]; F.a_log = (const float*)args.in[11]; F.dt_bias = (const float*)args.in[12]; F.gdn_norm_w = (const float*)args.in[13]; F.w_pa = (const float*)args.in[14];
    F.w_pb = (const float*)args.in[15]; F.w_o = (const float*)args.in[16]; F.norm_mlp_w = (const float*)args.in[17]; F.w_up = (const float*)args.in[18]; F.w_down = (const float*)args.in[19];
    F.norm_final_w = (const float*)args.in[20];
    for (int u = F.tid; u < (LDS_BYTES - LDSCTL_OFF) / 4; u += NTHR) ((LAS unsigned*)(F.lds + LDSCTL_OFF))[u] = 0u;
    __syncthreads();
    const int lo = args.ph_lo, hi = args.ph_hi;
    XcdBarrier bar; bar.bar = (unsigned*)(F.ctl + CW_BAR); bar.x = 0; bar.st = nullptr;
    if (hi - lo > 1) bar = xcd_barrier_post((unsigned*)(F.ctl + CW_BAR), F.MISC + 8);
#define IN(k) (lo <= (k) && (k) < hi)
#define REPS(k) _Pragma("unroll") for (int rep = 0; rep < 1 + ((PROBE_REPEAT_MASK >> (k)) & 1); ++rep)
#define REPBAR() do { if (rep) xcd_barrier(bar); } while (0)
#define SEAM(k) do { if (IN(k) && IN((k) + 1) && (k) != 4 && (k) != 1) xcd_barrier(bar); } while (0)
    LAS unsigned char* ring = F.lds + RING_OFF;
    unsigned long long pw_t0 = 0, pw_t1 = 0, pw_ta = 0, pw_tb = 0, pw_t4 = 0;
#define PW0(k) do { if (PROBE_WAIT_PHASE == (k)) pw_t0 = __builtin_amdgcn_s_memrealtime(); } while (0)
#define PW1(k) do { if (PROBE_WAIT_PHASE == (k)) pw_t1 = __builtin_amdgcn_s_memrealtime(); } while (0)

    if (PROBE_WAIT_PHASE >= 200) pw_t4 = __builtin_amdgcn_s_memrealtime();
    PW0(0); if (IN(0)) REPS(0) { REPBAR(); p0_prologue(F, pw_ta); if (PROBE_WAIT_PHASE == 201) pw_tb = __builtin_amdgcn_s_memrealtime(); } SEAM(0); PW1(0);
    PW0(1); if (IN(1)) REPS(1) { REPBAR();
        pg8::Gemm g{WSP(bf16, WS_XN), WSP(bf16, WS_WIN), M, NIN, DM, DM}; StaticOrder S; S.init(M, NIN, F.G, (int)blockIdx.x);
        EpiIn E{WSP(bf16, WS_QA), WSP(bf16, WS_KA), WSP(bf16, WS_VA), WSP(bf16, WS_ZB), WSP(bf16, WS_GA), WSP(bf16, WS_GB), WSP(float, WS_U), F.out};
        pg8::gemm_phase<EpiIn, StaticOrder, true, true>(ring, g, S, E);
    } SEAM(1); PW1(1);
    do { if (IN(1) && IN(3)) xcd_barrier(bar); } while (0);
    PW0(3); if (IN(3)) REPS(3) { REPBAR(); p3_gdn_prep(F, pw_t4, pw_ta, pw_tb); } SEAM(3); PW1(3);
    if (PROBE_WAIT_PHASE >= 100 && PROBE_WAIT_PHASE < 200) pw_t4 = __builtin_amdgcn_s_memrealtime();
    PW0(4); if (IN(4)) REPS(4) { REPBAR(); p4_mixers(F, rep * 128, pw_ta, pw_tb); } SEAM(4);
    do { if (IN(4) && IN(6)) xcd_barrier(bar); } while (0); PW1(4);
    PW0(6); if (IN(6)) REPS(6) { REPBAR(); p5_gdn_post(F); } SEAM(6); PW1(6);
    PW0(7); if (IN(7)) REPS(7) { REPBAR();
        pg8::Gemm g{WSP(bf16, WS_OCAT), WSP(bf16, WS_WCAT), MP, DM, 512, DM}; MergeOrder S{F.G, (int)blockIdx.x, (MP / 256) * 4};
        EpiMerge E{WSP(bf16, WS_GA), WSP(bf16, WS_GB), WSP(bf16, WS_MB)};
        pg8::gemm_phase<EpiMerge, MergeOrder, false, true>(ring, g, S, E);
        sample_merge(F);
    } SEAM(7); PW1(7);
    PW0(8); if (IN(8)) REPS(8) { REPBAR();
        pg8::Gemm g{WSP(bf16, WS_MB), WSP(bf16, WS_WO), MP, DM, DM, DM}; StaticOrder S; S.init(MP, DM, F.G, (int)blockIdx.x);
        EpiRes E{F.xp, F.xs, WSP(float, WS_X1), WSP(bf16, WS_X1B), (float*)(F.ctl + (rep ? CW_SSD : CW_SS1))};
        pg8::gemm_phase<EpiRes, StaticOrder, false, true>(ring, g, S, E);
        if (!rep) sample_wo(F);
    } SEAM(8); PW1(8);
    PW0(9); if (IN(9)) REPS(9) { REPBAR();
        pg8::Gemm g{WSP(bf16, WS_X1B), WSP(bf16, WS_WUP), MP, FF, DM, DM}; StaticOrder S; S.init(MP, FF, F.G, (int)blockIdx.x);
        EpiUp E{(const float*)(F.ctl + CW_SS1), WSP(bf16, WS_H)};
        pg8::gemm_phase<EpiUp, StaticOrder, true, true>(ring, g, S, E);
        sample_up(F);
    } SEAM(9); PW1(9);
    const bool fuse_final = (F.G == 256) && (PROBE_REPEAT_MASK == 0);
    PW0(10); if (IN(10)) REPS(10) { REPBAR();
        pg8::Gemm g{WSP(bf16, WS_H), WSP(bf16, WS_WDN), MP, DM, FF, FF}; StaticOrder S; S.init(MP, DM, F.G, (int)blockIdx.x);
        if (fuse_final) { EpiDownF E{WSP(float, WS_X1), F.out + O_Y, (float*)(F.ctl + CW_SS2), F.ctl + CW_PC, F.norm_final_w};
            pg8::gemm_phase<EpiDownF, StaticOrder, false, true>(ring, g, S, E); }
        else { EpiDown E{WSP(float, WS_X1), F.out + O_Y};
            pg8::gemm_phase<EpiDown, StaticOrder, false, true>(ring, g, S, E); }
        sample_down(F, fuse_final);
    } if (!fuse_final) SEAM(10); PW1(10);
    PW0(11); if (IN(11) && !fuse_final) { p10_final(F); } PW1(11);
    if (PROBE_WAIT_PHASE >= 300) { pw_t0 = PROBE_WAIT_PHASE == 300 ? pw_t4 : pw_ta; pw_t1 = PROBE_WAIT_PHASE == 300 ? pw_ta : pw_tb;
        if (blockIdx.x == 0) { const unsigned long long tw = __builtin_amdgcn_s_memrealtime(); while (__builtin_amdgcn_s_memrealtime() - tw < pw_t1 - pw_t0) __builtin_amdgcn_s_sleep(8); } }
    else if (PROBE_WAIT_PHASE >= 200) { pw_t0 = PROBE_WAIT_PHASE == 200 ? pw_t4 : pw_ta; pw_t1 = PROBE_WAIT_PHASE == 200 ? pw_ta : pw_tb;
        if (blockIdx.x == 0) { const unsigned long long tw = __builtin_amdgcn_s_memrealtime(); while (__builtin_amdgcn_s_memrealtime() - tw < pw_t1 - pw_t0) __builtin_amdgcn_s_sleep(8); } }
    else if (PROBE_WAIT_PHASE >= 100) { const int wb = PROBE_WAIT_PHASE == 100 ? 0 : PROBE_WAIT_PHASE == 102 ? 16 : 8; pw_t0 = pw_t4; pw_t1 = (PROBE_WAIT_PHASE == 102 || PROBE_WAIT_PHASE == 103) ? pw_tb : pw_ta;
        if ((int)blockIdx.x == wb) { const unsigned long long tw = __builtin_amdgcn_s_memrealtime(); while (__builtin_amdgcn_s_memrealtime() - tw < pw_t1 - pw_t0) __builtin_amdgcn_s_sleep(8); } }
    else if (PROBE_WAIT_PHASE >= 0 && blockIdx.x == 0) { const unsigned long long tw = __builtin_amdgcn_s_memrealtime(); while (__builtin_amdgcn_s_memrealtime() - tw < pw_t1 - pw_t0) __builtin_amdgcn_s_sleep(8); }
#undef IN
#undef SEAM
}

extern "C" void kernel_launch(void* const* d_in, const int* in_sizes, int n_in, void* d_out, int out_size, void* d_ws, size_t ws_size, hipStream_t stream) {
    static int grid = 0;
    if (grid == 0) {
        if (n_in != 21 || out_size != (int)O_END || ws_size < WS_END) { fprintf(stderr, "kernel_launch: unexpected shapes (n_in %d, out %d, ws %zu); nothing launched\n", n_in, out_size, ws_size); grid = -1; return; }
        int dev = 0, cus = 0, per_cu = 0;
        if (hipGetDevice(&dev) != hipSuccess || hipDeviceGetAttribute(&cus, hipDeviceAttributeMultiprocessorCount, dev) != hipSuccess) { grid = -1; return; }
        if (hipFuncSetAttribute((const void*)mk_fwd, hipFuncAttributeMaxDynamicSharedMemorySize, LDS_BYTES) != hipSuccess) { fprintf(stderr, "kernel_launch: hipFuncSetAttribute failed\n"); grid = -1; return; }
        if (hipOccupancyMaxActiveBlocksPerMultiprocessor(&per_cu, (const void*)mk_fwd, NTHR, LDS_BYTES) != hipSuccess || per_cu < 1) { fprintf(stderr, "kernel_launch: occupancy query says %d\n", per_cu); }
        (void)hipGetLastError();
        grid = cus;
    }
    if (grid < 0) return;
    if (hipMemsetAsync((char*)d_ws + WS_CTL, 0, CTL_ZERO_BYTES, stream) != hipSuccess) return;
    Args a{};
    for (int i = 0; i < 21; ++i) a.in[i] = d_in[i];
    a.out = (float*)d_out; a.ws = (unsigned char*)d_ws;
    if (MK_N_LAUNCHES == 1) { a.ph_lo = 0; a.ph_hi = N_PHASES; hipLaunchKernelGGL(mk_fwd, dim3(grid), dim3(NTHR), LDS_BYTES, stream, a); }
    else for (int p = 0; p < N_PHASES; ++p) { a.ph_lo = p; a.ph_hi = p + 1; hipLaunchKernelGGL(mk_fwd, dim3(grid), dim3(NTHR), LDS_BYTES, stream, a); }
}
```
